# Optimizing an MI355X kernel written in HIP

```python
import jax, jax.numpy as jnp
from jax import lax
import numpy as np

D_MODEL = 2048
BATCH = 4
SEQ = 4096
DEPTH = 4

CHUNK = 64
QBLOCK = 128
N_A_LAYERS = DEPTH // 2
N_B_LAYERS = DEPTH - N_A_LAYERS
EXPAND = 2
W_A = EXPAND * D_MODEL
POOL_WINDOWS = (2, 4, 8, 16)
N_POOL_GROUPS = len(POOL_WINDOWS)
G_A = W_A // N_POOL_GROUPS
N_HEADS = 16
QK_NOPE = 128
QK_ROPE = 64
QK_HEAD = QK_NOPE + QK_ROPE
V_HEAD = 128
KV_LORA = 512
Q_LORA = 512
W_B = N_HEADS * V_HEAD
ROPE_THETA = 10000.0
EPS = 1e-6

kernel_name = "yoco_pool_mla_gated_hybrid"


def rmsnorm(x, g):
    x32 = x.astype(jnp.float32)
    r = x32 * lax.rsqrt(jnp.mean(x32 * x32, axis=-1, keepdims=True) + EPS)
    return (r * g.astype(jnp.float32)).astype(x.dtype)


def rope_tables(positions):
    inv = ROPE_THETA ** (-jnp.arange(0, QK_ROPE, 2, dtype=jnp.float32) / QK_ROPE)
    ang = positions.astype(jnp.float32)[..., None] * inv
    return jnp.cos(ang), jnp.sin(ang)


def apply_rope(t, cos, sin):
    c = cos[:, :, None, :].astype(t.dtype)
    s = sin[:, :, None, :].astype(t.dtype)
    t1, t2 = t[..., : QK_ROPE // 2], t[..., QK_ROPE // 2:]
    return jnp.concatenate([t1 * c - t2 * s, t2 * c + t1 * s], axis=-1)


def qk_norm_rope(t, g, cos, sin):
    t = rmsnorm(t, g)
    return jnp.concatenate([t[..., :QK_NOPE], apply_rope(t[..., QK_NOPE:], cos, sin)], axis=-1)


def causal_mean_pool(u, w):
    B, S, C = u.shape
    u32 = u.astype(jnp.float32)
    c0 = jnp.concatenate([jnp.zeros((B, 1, C), jnp.float32), jnp.cumsum(u32, axis=1)], axis=1)
    padded = jnp.pad(c0, ((0, 0), (w - 1, 0), (0, 0)))
    window_sum = c0[:, 1:] - padded[:, :S]
    count = jnp.minimum(jnp.arange(1, S + 1, dtype=jnp.float32), float(w))
    return (window_sum / count[None, :, None]).astype(u.dtype)


def pool_mixer_layer(x, norm_g, w_in, w_group, scale, w_out):
    B, S, _ = x.shape
    h = rmsnorm(x, norm_g)
    proj = h @ w_in
    u, gate = proj[..., :W_A], proj[..., W_A:]
    u = u.reshape(B, S, N_POOL_GROUPS, G_A)
    pooled = jnp.stack(
        [causal_mean_pool(u[:, :, gi], w) - u[:, :, gi] for gi, w in enumerate(POOL_WINDOWS)],
        axis=2)
    y = jnp.einsum('bsgc,gcd->bsgd', pooled, w_group).reshape(B, S, W_A) * scale
    y = y * jax.nn.silu(gate)
    return x + y @ w_out


def shared_kv(x, kv_norm_g, kv_w_a, kv_latent_g, kv_w_b, k_norm_g, cos, sin):
    B, S, _ = x.shape
    h = rmsnorm(x, kv_norm_g)
    ckv = h @ kv_w_a
    c, k_rope = ckv[..., :KV_LORA], ckv[..., KV_LORA:]
    c = rmsnorm(c, kv_latent_g)
    kv = (c @ kv_w_b).reshape(B, S, N_HEADS, QK_NOPE + V_HEAD)
    k_nope, v = kv[..., :QK_NOPE], kv[..., QK_NOPE:]
    k_rope = jnp.broadcast_to(k_rope[:, :, None, :], (B, S, N_HEADS, QK_ROPE))
    k = qk_norm_rope(jnp.concatenate([k_nope, k_rope], axis=-1), k_norm_g, cos, sin)
    return k, v


def chunk_causal_attention(q, k, v):
    S = q.shape[1]
    scale = QK_HEAD ** -0.5
    outs = []
    for i in range(S // QBLOCK):
        q0, k_end = i * QBLOCK, (i + 1) * QBLOCK
        s = jnp.einsum('bqhd,bkhd->bhqk', q[:, q0:k_end], k[:, :k_end],
                       preferred_element_type=jnp.float32) * scale
        q_chunk = (q0 + jnp.arange(QBLOCK)) // CHUNK
        k_chunk = jnp.arange(k_end) // CHUNK
        mask = k_chunk[None, :] <= q_chunk[:, None]
        s = jnp.where(mask[None, None], s, -1e30)
        p = jax.nn.softmax(s, axis=-1).astype(v.dtype)
        outs.append(jnp.einsum('bhqk,bkhd->bqhd', p, v[:, :k_end]))
    return jnp.concatenate(outs, axis=1)


def mla_layer(x, k, v, norm_g, w_in, q_latent_g, w_q_b, q_norm_g, w_out, cos, sin):
    B, S, _ = x.shape
    h = rmsnorm(x, norm_g)
    proj = h @ w_in
    q_lat, gate = proj[..., :Q_LORA], proj[..., Q_LORA:]
    q = (rmsnorm(q_lat, q_latent_g) @ w_q_b).reshape(B, S, N_HEADS, QK_HEAD)
    q = qk_norm_rope(q, q_norm_g, cos, sin)
    o = chunk_causal_attention(q, k, v).reshape(B, S, W_B)
    return x + (o * jax.nn.silu(gate)) @ w_out


def setup_inputs(seed: int = 0) -> dict:
    key = jax.random.key(seed)
    ks = jax.random.split(key, 24)
    f32 = jnp.float32

    def w(k, shape, fan_in):
        return jax.random.normal(k, shape, f32) * (fan_in ** -0.5)

    def gain(k, shape):
        return 1.0 + 0.02 * jax.random.normal(k, shape, f32)

    x = jax.random.normal(ks[0], (BATCH, SEQ, D_MODEL), f32)
    offsets = jax.random.randint(ks[1], (BATCH,), 0, 64, dtype=jnp.int32) * CHUNK
    positions = (offsets[:, None] + jnp.arange(SEQ, dtype=jnp.int32)[None, :]).astype(jnp.int32)
    return {
        "x": x,
        "positions": positions,
        "a_norm_g": gain(ks[2], (N_A_LAYERS, D_MODEL)),
        "a_w_in": w(ks[3], (N_A_LAYERS, D_MODEL, 2 * W_A), D_MODEL),
        "a_w_group": w(ks[4], (N_A_LAYERS, N_POOL_GROUPS, G_A, G_A), G_A),
        "a_scale": gain(ks[5], (N_A_LAYERS, W_A)),
        "a_w_out": w(ks[6], (N_A_LAYERS, W_A, D_MODEL), W_A),
        "kv_norm_g": gain(ks[7], (D_MODEL,)),
        "kv_w_a": w(ks[8], (D_MODEL, KV_LORA + QK_ROPE), D_MODEL),
        "kv_latent_g": gain(ks[9], (KV_LORA,)),
        "kv_w_b": w(ks[10], (KV_LORA, N_HEADS * (QK_NOPE + V_HEAD)), KV_LORA),
        "k_norm_g": gain(ks[11], (QK_HEAD,)),
        "b_norm_g": gain(ks[12], (N_B_LAYERS, D_MODEL)),
        "b_w_in": w(ks[13], (N_B_LAYERS, D_MODEL, Q_LORA + W_B), D_MODEL),
        "b_q_latent_g": gain(ks[14], (N_B_LAYERS, Q_LORA)),
        "b_w_q_b": w(ks[15], (N_B_LAYERS, Q_LORA, N_HEADS * QK_HEAD), Q_LORA),
        "b_q_norm_g": gain(ks[16], (N_B_LAYERS, QK_HEAD)),
        "b_w_out": w(ks[17], (N_B_LAYERS, W_B, D_MODEL), W_B),
    }


def reference(x, positions, a_norm_g, a_w_in, a_w_group, a_scale, a_w_out,
              kv_norm_g, kv_w_a, kv_latent_g, kv_w_b, k_norm_g,
              b_norm_g, b_w_in, b_q_latent_g, b_w_q_b, b_q_norm_g, b_w_out):
    cos, sin = rope_tables(positions)
    k = v = None
    for layer in range(DEPTH):
        if layer < N_A_LAYERS:
            x = pool_mixer_layer(x, a_norm_g[layer], a_w_in[layer], a_w_group[layer],
                                 a_scale[layer], a_w_out[layer])
        else:
            if layer == N_A_LAYERS:
                k, v = shared_kv(x, kv_norm_g, kv_w_a, kv_latent_g, kv_w_b, k_norm_g, cos, sin)
            j = layer - N_A_LAYERS
            x = mla_layer(x, k, v, b_norm_g[j], b_w_in[j], b_q_latent_g[j], b_w_q_b[j],
                          b_q_norm_g[j], b_w_out[j], cos, sin)
    return x
```

```cpp
#include <hip/hip_runtime.h>
#include <hip/hip_cooperative_groups.h>
#include <hip/hip_bf16.h>
#include <cstdio>
#include <cstdint>
namespace cg = cooperative_groups;

namespace pg8 {
#define PG8_LAS __attribute__((address_space(3)))
typedef unsigned short bf16_t;
typedef short bf16x8 __attribute__((ext_vector_type(8)));
typedef float f32x4 __attribute__((ext_vector_type(4)));
typedef unsigned u32x4 __attribute__((ext_vector_type(4)));
constexpr int BM = 256, BK = 64, HALF = 128, HTB = HALF * BK * 2  , STAGE_BYTES = 8 * HTB, NXCD = 8, WGM = 8;

__host__ __device__ __forceinline__ int lds_byte(int r, int c) { const int st = (r >> 4) * 2 + (c >> 5), rr = r & 15, cc = c & 31, ob = rr * 64 + cc * 2; return st * 1024 + (ob ^ (((ob >> 9) & 1) << 5)); }
__host__ __device__ __forceinline__ void stage_rc(int b, int& R, int& C) { const int st = b / 1024, sb = b % 1024, swz = sb ^ (((sb >> 9) & 1) << 5); R = (st >> 1) * 16 + swz / 64; C = (st & 1) * 32 + (swz % 64) / 2; }
__host__ __device__ __forceinline__ int perm32(int rho) { const int n = rho >> 4, i = rho & 15; return 8 * (i >> 2) + 4 * n + (i & 3); }

struct Unit { int pm, pn; };
struct Gemm { const bf16_t* A; const bf16_t* Bt; int M, N, K, lda, ldb, agdiv, agstep, bgdiv, bgstep; };

struct StaticOrder {
    int nM, nN, nwg, G, c;
    __host__ __device__ void init(int M, int N, int G_, int c_) { nM = M / BM; nN = N / BM; nwg = nM * nN; G = G_; c = c_; }
    __host__ __device__ bool next(int i, Unit& u) const {
        const long L = (long)i * G + c; if (L >= nwg) return false;
        int wgid = (int)L; { const int q = nwg / NXCD, r = nwg % NXCD, xcd = wgid % NXCD, off = wgid / NXCD; wgid = (xcd < r ? xcd * (q + 1) : r * (q + 1) + (xcd - r) * q) + off; }
        const int nig = WGM * nN, gid = wgid / nig, fm = gid * WGM, gsz = (nM - fm) < WGM ? (nM - fm) : WGM;
        u.pm = fm + ((wgid % nig) % gsz); u.pn = (wgid % nig) / gsz; return true;
    }
    __device__ __forceinline__ void a_ready(const Unit&) const {}
    __device__ __forceinline__ void done(const Unit&) const {}
};

#define PG8_UA(u) ((const char*)g.A + (size_t)(u).pm * tstepA + (size_t)((u).pn / g.agdiv) * (size_t)g.agstep * 2)
#define PG8_UB(u) ((const char*)g.Bt + (size_t)(u).pn * tstepB + (size_t)((u).pm / g.bgdiv) * (size_t)g.bgstep * 2)
template <class Epi, class Sched, bool ALIGN_EPI = false, bool SP2 = false>
__device__ __forceinline__ void gemm_phase(PG8_LAS unsigned char* lds, const Gemm g, const Sched& S, const Epi& E) {
    int tid_l = threadIdx.x; asm volatile("" : "+v"(tid_l));
    const int tid = tid_l, wid = __builtin_amdgcn_readfirstlane(tid >> 6), lane = tid & 63, wr = wid >> 2, wc = wid & 3, fr = lane & 15, fq = lane >> 4;
    const int K = g.K, nt = K / BK;
    unsigned voffA[2], voffB[2];
#pragma unroll
    for (int i = 0; i < 2; ++i) { int R, C; stage_rc(tid * 16 + i * 8192, R, C); const int Rb = Epi::PERM ? ((R & ~31) + perm32(R & 31)) : R;
        voffA[i] = (unsigned)(R * g.lda + C) * 2u; voffB[i] = (unsigned)(Rb * g.ldb + C) * 2u; }
    const size_t kstep = (size_t)(BK * 2);
    const size_t hstepA = (size_t)HALF * g.lda * 2, hstepB = (size_t)HALF * g.ldb * 2;
    const size_t tstepA = 2 * hstepA, tstepB = 2 * hstepB;
    const unsigned ldsw = (unsigned)wid * 1024u;
    const int aoff = lds_byte(wr * 64 + fr, fq * 8), boff = lds_byte(wc * 32 + fr, fq * 8);
#define PG8_SA(b, h) (((b) * 2 + (h)) * HTB)
#define PG8_SB(b, h) ((4 + (b) * 2 + (h)) * HTB)
#define PG8_STAGE(bufoff, gbase, voff) do { _Pragma("unroll") for (int _i = 0; _i < 2; ++_i) \
        __builtin_amdgcn_global_load_lds((const unsigned*)((const char*)(gbase) + (voff)[_i]), (PG8_LAS unsigned*)(lds + (bufoff) + ldsw + _i * 8192), 16, 0, 0); } while (0)
#define PG8_LDA(dst, b, h) do { _Pragma("unroll") for (int m = 0; m < 4; ++m) _Pragma("unroll") for (int k = 0; k < 2; ++k) dst[m][k] = *(const PG8_LAS bf16x8*)(lds + PG8_SA(b, h) + aoff + m * 2048 + k * 1024); } while (0)
#define PG8_LDB(dst, b, h) do { _Pragma("unroll") for (int n = 0; n < 2; ++n) _Pragma("unroll") for (int k = 0; k < 2; ++k) dst[n][k] = *(const PG8_LAS bf16x8*)(lds + PG8_SB(b, h) + boff + n * 2048 + k * 1024); } while (0)
#define PG8_MMA(ai, bj, At, Bt) do { __builtin_amdgcn_s_setprio(1); _Pragma("unroll") for (int m = 0; m < 4; ++m) _Pragma("unroll") for (int n = 0; n < 2; ++n) _Pragma("unroll") for (int k = 0; k < 2; ++k) \
        acc[ai][bj][m][n] = __builtin_amdgcn_mfma_f32_16x16x32_bf16(Bt[n][k], At[m][k], acc[ai][bj][m][n], 0, 0, 0); __builtin_amdgcn_s_setprio(0); } while (0)
#define PG8_WAIT_V(n) asm volatile("s_waitcnt vmcnt(" #n ")" ::: "memory")
#define PG8_WAIT_L(n) asm volatile("s_waitcnt lgkmcnt(" #n ")" ::: "memory")
#define PG8_BAR __builtin_amdgcn_s_barrier()
#define PG8_SCHED __builtin_amdgcn_sched_barrier(0)
    Unit cur, nxt; int ui = 0;
    if (!S.next(0, cur)) return;
    f32x4 acc[2][2][4][2];
#pragma unroll
    for (int a = 0; a < 2; ++a)
#pragma unroll
        for (int b = 0; b < 2; ++b)
#pragma unroll
            for (int m = 0; m < 4; ++m)
#pragma unroll
                for (int n = 0; n < 2; ++n) acc[a][b][m][n] = (f32x4){0.f, 0.f, 0.f, 0.f};
    bf16x8 At[4][2], B0[2][2], B1[2][2];
    const char* cA = PG8_UA(cur); const char* cB = PG8_UB(cur);
    S.a_ready(cur);
    if constexpr (SP2) {
        PG8_STAGE(PG8_SB(0, 0), cB, voffB); PG8_STAGE(PG8_SB(0, 1), cB + hstepB, voffB); PG8_STAGE(PG8_SA(0, 0), cA, voffA); PG8_STAGE(PG8_SA(0, 1), cA + hstepA, voffA);
        if (wr == 1) PG8_BAR;
        PG8_WAIT_V(2); PG8_BAR;
        PG8_STAGE(PG8_SB(1, 0), cB + kstep, voffB); PG8_STAGE(PG8_SA(1, 0), cA + kstep, voffA); PG8_STAGE(PG8_SB(1, 1), cB + hstepB + kstep, voffB);
        PG8_WAIT_V(6); PG8_BAR;
    } else {
        PG8_STAGE(PG8_SB(0, 0), cB, voffB); PG8_STAGE(PG8_SA(0, 0), cA, voffA); PG8_STAGE(PG8_SB(0, 1), cB + hstepB, voffB); PG8_STAGE(PG8_SA(0, 1), cA + hstepA, voffA);
        if (wr == 1) PG8_BAR;
        PG8_WAIT_V(4); PG8_BAR;
        PG8_STAGE(PG8_SB(1, 0), cB + kstep, voffB); PG8_STAGE(PG8_SA(1, 0), cA + kstep, voffA); PG8_STAGE(PG8_SB(1, 1), cB + hstepB + kstep, voffB);
        PG8_WAIT_V(6); PG8_BAR;
    }
    for (;;) {
        const bool has_next = S.next(ui + 1, nxt);
        const char* nA = has_next ? PG8_UA(nxt) : cA; const char* nB = has_next ? PG8_UB(nxt) : cB;
        for (int t = 0; t < nt; t += 2) {
            const bool last = (t == nt - 2);
            const char* a1 = cA + (size_t)(t + 1) * kstep;
            const char* a2 = last ? nA : cA + (size_t)(t + 2) * kstep; const char* b2 = last ? nB : cB + (size_t)(t + 2) * kstep;
            const char* a3 = a2 + kstep; const char* b3 = b2 + kstep;
            if (last && has_next) S.a_ready(nxt);
            if constexpr (SP2) {
            PG8_LDB(B0, 0, 0); PG8_LDB(B1, 0, 1); PG8_SCHED; PG8_LDA(At, 0, 0); PG8_STAGE(PG8_SA(1, 1), a1 + hstepA, voffA);
            PG8_WAIT_V(8); PG8_WAIT_L(0); PG8_BAR; PG8_MMA(0, 0, At, B0); PG8_MMA(0, 1, At, B1); PG8_BAR; PG8_SCHED;
            PG8_LDA(At, 0, 1); PG8_STAGE(PG8_SB(0, 0), b2, voffB); PG8_STAGE(PG8_SB(0, 1), b2 + hstepB, voffB); PG8_STAGE(PG8_SA(0, 0), a2, voffA);
            PG8_WAIT_V(8); PG8_WAIT_L(0); PG8_BAR; PG8_MMA(1, 0, At, B0); PG8_MMA(1, 1, At, B1); PG8_BAR; PG8_SCHED;
            PG8_LDB(B0, 1, 0); PG8_LDB(B1, 1, 1); PG8_SCHED; PG8_LDA(At, 1, 0); PG8_STAGE(PG8_SA(0, 1), a2 + hstepA, voffA);
            PG8_WAIT_V(8); PG8_WAIT_L(0); PG8_BAR; PG8_MMA(0, 0, At, B0); PG8_MMA(0, 1, At, B1); PG8_BAR; PG8_SCHED;
            PG8_LDA(At, 1, 1); PG8_STAGE(PG8_SB(1, 0), b3, voffB); PG8_STAGE(PG8_SB(1, 1), b3 + hstepB, voffB); PG8_STAGE(PG8_SA(1, 0), a3, voffA);
            PG8_WAIT_V(8); PG8_WAIT_L(0); PG8_BAR; PG8_MMA(1, 0, At, B0); PG8_MMA(1, 1, At, B1); PG8_BAR; PG8_SCHED;
            } else {
            PG8_LDB(B0, 0, 0); PG8_SCHED; PG8_LDA(At, 0, 0); PG8_STAGE(PG8_SA(1, 1), a1 + hstepA, voffA);
            PG8_WAIT_L(8); PG8_BAR; PG8_WAIT_L(0); PG8_MMA(0, 0, At, B0); PG8_BAR; PG8_SCHED;
            PG8_LDB(B1, 0, 1); PG8_STAGE(PG8_SB(0, 0), b2, voffB);
            PG8_BAR; PG8_WAIT_L(0); PG8_MMA(0, 1, At, B1); PG8_BAR;
            PG8_LDA(At, 0, 1); PG8_STAGE(PG8_SA(0, 0), a2, voffA);
            PG8_BAR; PG8_WAIT_L(0); PG8_MMA(1, 0, At, B0); PG8_BAR; PG8_SCHED;
            PG8_STAGE(PG8_SB(0, 1), b2 + hstepB, voffB);
            PG8_WAIT_V(6); PG8_BAR; PG8_MMA(1, 1, At, B1); PG8_BAR;
            PG8_LDB(B0, 1, 0); PG8_SCHED; PG8_LDA(At, 1, 0); PG8_STAGE(PG8_SA(0, 1), a2 + hstepA, voffA);
            PG8_WAIT_L(8); PG8_BAR; PG8_WAIT_L(0); PG8_MMA(0, 0, At, B0); PG8_BAR; PG8_SCHED;
            PG8_LDB(B1, 1, 1); PG8_STAGE(PG8_SB(1, 0), b3, voffB);
            PG8_BAR; PG8_WAIT_L(0); PG8_MMA(0, 1, At, B1); PG8_BAR;
            PG8_LDA(At, 1, 1); PG8_STAGE(PG8_SA(1, 0), a3, voffA);
            PG8_BAR; PG8_WAIT_L(0); PG8_MMA(1, 0, At, B0); PG8_BAR; PG8_SCHED;
            PG8_STAGE(PG8_SB(1, 1), b3 + hstepB, voffB);
            PG8_WAIT_V(6); PG8_BAR; PG8_MMA(1, 1, At, B1); PG8_BAR;
            }
        }
        if constexpr (ALIGN_EPI) { if (wr == 0) PG8_BAR; }
        if constexpr (!Epi::AFTER_DRAIN) { E(acc, cur, wr, wc, fr, fq); S.done(cur); }
        if (!has_next) break;
#pragma unroll
        for (int a = 0; a < 2; ++a)
#pragma unroll
            for (int b = 0; b < 2; ++b)
#pragma unroll
                for (int m = 0; m < 4; ++m)
#pragma unroll
                    for (int n = 0; n < 2; ++n) acc[a][b][m][n] = (f32x4){0.f, 0.f, 0.f, 0.f};
        cur = nxt; cA = nA; cB = nB; ++ui;
        if constexpr (ALIGN_EPI) { if (wr == 1) PG8_BAR; }
    }
    PG8_WAIT_V(0);
    if constexpr (!ALIGN_EPI) { if (wr == 0) PG8_BAR; }
    PG8_BAR;
    if constexpr (Epi::AFTER_DRAIN) { E.fused(acc, cur, wr, wc, fr, fq, lds, wid, lane); S.done(cur); }
#undef PG8_SA
#undef PG8_SB
#undef PG8_STAGE
#undef PG8_LDA
#undef PG8_LDB
#undef PG8_MMA
#undef PG8_WAIT_V
#undef PG8_WAIT_L
#undef PG8_BAR
#undef PG8_SCHED
}
}

constexpr int DM = 2048, NB = 4, SEQ = 4096, MTOK = NB * SEQ;
constexpr int WA = 4096, GA = 1024, NH = 16, QKN = 128, QKR = 64, QKH = 192, VH = 128, KVL = 512, QL_ = 512, WB = 2048;
constexpr float EPS = 1e-6f;

typedef unsigned short bf16_t;
typedef float f32x4 __attribute__((ext_vector_type(4)));
typedef unsigned u32x4 __attribute__((ext_vector_type(4)));
typedef unsigned u32x2 __attribute__((ext_vector_type(2)));
typedef short bf16x8 __attribute__((ext_vector_type(8)));
#define LAS __attribute__((address_space(3)))

constexpr size_t MiB = 1u << 20;
constexpr size_t WS_COS = 0, WS_SIN = 2 * MiB, WS_SSQC = 4 * MiB, WS_SSQQ0 = 4 * MiB + 65536, WS_SSQQ1 = 4 * MiB + 131072, WS_SSQX = 4 * MiB + 196608  , WS_SSQKR = 4 * MiB + 458752  , WS_KR = 5 * MiB;
constexpr size_t WS_BAR = 9 * MiB;
constexpr size_t WS_W = 10 * MiB;
constexpr size_t WS_AWIN = WS_W, WS_AWG = WS_W + 32 * MiB, WS_AWOUT = WS_W + 40 * MiB;
constexpr size_t WS_BWC0 = WS_W, WS_BWIN1 = WS_W + 13 * MiB, WS_BWKVB = WS_W + 23 * MiB, WS_BWQB0 = WS_W + 27 * MiB, WS_BWQB1 = WS_W + 30 * MiB, WS_BWO0 = WS_W + 33 * MiB, WS_BWO1 = WS_W + 41 * MiB;
constexpr size_t WS_ACT = 66 * MiB;
constexpr size_t WS_XN = WS_ACT, WS_R0 = WS_ACT, WS_R1 = WS_ACT + 128 * MiB, WS_G = WS_ACT + 256 * MiB;
constexpr size_t WS_AWGB = WS_G, WS_WINUB = WS_G + 16 * MiB;
constexpr size_t WS_GB = WS_ACT + 64 * MiB, WS_OG = WS_GB  , WS_CB = WS_ACT + 128 * MiB, WS_QL = WS_ACT + 144 * MiB, WS_K = WS_ACT + 160 * MiB, WS_V = WS_ACT + 256 * MiB, WS_Q = WS_ACT + 320 * MiB;
constexpr size_t WS_W2 = 450 * MiB, WS_A1WIN = WS_W2, WS_A1WG = WS_W2 + 32 * MiB, WS_A1WOUT = WS_W2 + 40 * MiB;
constexpr size_t WS_XB2 = WS_ACT;
constexpr size_t WS_END = 506 * MiB;
constexpr int LDS_BYTES = 131072 + 8192, XCH_OFF = 131072  , MISC_OFF = 131072 + 4096;

__device__ __forceinline__ unsigned f2bf(float f) { unsigned u = __builtin_bit_cast(unsigned, f); return (u + 0x7fffu + ((u >> 16) & 1u)) >> 16; }
__device__ __forceinline__ unsigned pk2(float lo, float hi) { unsigned r; asm volatile("v_cvt_pk_bf16_f32 %0, %1, %2" : "=v"(r) : "v"(lo), "v"(hi)); return r; }
__device__ __forceinline__ float bflo(unsigned w) { return __builtin_bit_cast(float, w << 16); }
__device__ __forceinline__ float bfhi(unsigned w) { return __builtin_bit_cast(float, w & 0xffff0000u); }
__device__ __forceinline__ float silu_f(float v) { return v * __builtin_amdgcn_rcpf(1.0f + __builtin_amdgcn_exp2f(-1.4426950408889634f * v)); }
__device__ __forceinline__ float sum_fq(float v) {
    { auto rr = __builtin_amdgcn_permlane16_swap(__float_as_uint(v), __float_as_uint(v), false, false); v = __uint_as_float(rr[0]) + __uint_as_float(rr[1]); }
    { auto rr = __builtin_amdgcn_permlane32_swap(__float_as_uint(v), __float_as_uint(v), false, false); v = __uint_as_float(rr[0]) + __uint_as_float(rr[1]); }
    return v;
}
__device__ __forceinline__ float wave_sum(float v) {
#pragma unroll
    for (int o = 1; o < 64; o <<= 1) v += __shfl_xor(v, o);
    return v;
}

typedef const f32x4 (&AccT)[2][2][4][2];
#define EPI_ROWS(...) _Pragma("unroll") for (int ai = 0; ai < 2; ++ai) _Pragma("unroll") for (int m = 0; m < 4; ++m) { const int row = u.pm * 256 + ai * 128 + wr * 64 + m * 16 + fr; __VA_ARGS__ }
__device__ __forceinline__ u32x4 pack8(f32x4 a, f32x4 b) { u32x4 w; w.x = pk2(a[0], a[1]); w.y = pk2(a[2], a[3]); w.z = pk2(b[0], b[1]); w.w = pk2(b[2], b[3]); return w; }
__device__ __forceinline__ f32x4 silu4(f32x4 v) { return (f32x4){silu_f(v[0]), silu_f(v[1]), silu_f(v[2]), silu_f(v[3])}; }

struct EpiA1 {
    static constexpr bool PERM = true, AFTER_DRAIN = false, ALIGN = true;
    bf16_t* U; bf16_t* G; const float* ssqx;
    __device__ __forceinline__ void operator()(AccT acc, const pg8::Unit& u, int wr, int wc, int fr, int fq) const {
        const bool isg = u.pn >= 16; bf16_t* base = isg ? G : U; const int col0 = (isg ? u.pn - 16 : u.pn) * 256 + wc * 32 + fq * 8;
        EPI_ROWS(
            const float rx = 1.0f / sqrtf(ssqx[row] * (1.0f / DM) + EPS);
            _Pragma("unroll") for (int bj = 0; bj < 2; ++bj) { f32x4 v0 = acc[ai][bj][m][0] * rx, v1 = acc[ai][bj][m][1] * rx;
                if (isg) { v0 = silu4(v0); v1 = silu4(v1); }
                *(u32x4*)(base + (size_t)row * WA + col0 + bj * 128) = pack8(v0, v1); }
        )
    }
};
struct EpiWp {
    static constexpr bool PERM = true, AFTER_DRAIN = false, ALIGN = true;
    bf16_t* o0; bf16_t* o1;
    __device__ __forceinline__ void operator()(AccT acc, const pg8::Unit& u, int wr, int wc, int fr, int fq) const {
        const int col0 = u.pn * 256 + wc * 32 + fq * 8;
        EPI_ROWS(
            bf16_t* base = (row < WA ? o0 : o1) + (size_t)(row & (WA - 1)) * DM + col0;
            _Pragma("unroll") for (int bj = 0; bj < 2; ++bj) *(u32x4*)(base + bj * 128) = pack8(acc[ai][bj][m][0], acc[ai][bj][m][1]);
        )
    }
};
struct EpiRes {
    static constexpr bool PERM = true, AFTER_DRAIN = false, ALIGN = true;
    const bf16_t* res; float* out; bf16_t* xb; float* ssq;
    __device__ __forceinline__ void operator()(AccT acc, const pg8::Unit& u, int wr, int wc, int fr, int fq) const {
        const int col0 = u.pn * 256 + wc * 32 + fq * 8;
        EPI_ROWS(
            float s = 0.f;
            _Pragma("unroll") for (int bj = 0; bj < 2; ++bj) { const size_t off = (size_t)row * DM + col0 + bj * 128;
                const u32x4 rb = *(const u32x4*)(res + off);
                const f32x4 r0 = (f32x4){bflo(rb.x), bfhi(rb.x), bflo(rb.y), bfhi(rb.y)} + acc[ai][bj][m][0], r1 = (f32x4){bflo(rb.z), bfhi(rb.z), bflo(rb.w), bfhi(rb.w)} + acc[ai][bj][m][1];
                if (out) { *(f32x4*)(out + off) = r0; *(f32x4*)(out + off + 4) = r1; }
                if (xb) { *(u32x4*)(xb + off) = pack8(r0, r1);
                    s += (r0[0] * r0[0] + r0[1] * r0[1]) + (r0[2] * r0[2] + r0[3] * r0[3]) + (r1[0] * r1[0] + r1[1] * r1[1]) + (r1[2] * r1[2] + r1[3] * r1[3]); } }
            if (xb) { s = sum_fq(s); if (fq == 0) atomicAdd(ssq + row, s); }
        )
    }
};
struct EpiBin {
    static constexpr bool PERM = true, AFTER_DRAIN = false, ALIGN = true;
    bf16_t* Cb; bf16_t* QL; bf16_t* Gb; float* KR; float* ssqc; float* ssqq; int toff; const float* ssqx; float* ssqkr;
    __device__ __forceinline__ void operator()(AccT acc, const pg8::Unit& u, int wr, int wc, int fr, int fq) const {
        const int t = u.pn + toff; const int cw = wc * 32 + fq * 8;
        if (t >= 5) {
            const int col0 = (t - 5) * 256 + cw;
            EPI_ROWS(
                const float rx = 1.0f / sqrtf(ssqx[row] * (1.0f / DM) + EPS);
                _Pragma("unroll") for (int bj = 0; bj < 2; ++bj)
                    *(u32x4*)(Gb + (size_t)row * WB + col0 + bj * 128) = pack8(silu4(acc[ai][bj][m][0] * rx), silu4(acc[ai][bj][m][1] * rx));
            )
        } else if (t == 2) {
            if (wc < 2) {
                EPI_ROWS(
                    const float rx = 1.0f / sqrtf(ssqx[row] * (1.0f / DM) + EPS);
                    const f32x4 v0 = acc[ai][0][m][0] * rx, v1 = acc[ai][0][m][1] * rx;
                    *(f32x4*)(KR + (size_t)row * 64 + cw) = v0; *(f32x4*)(KR + (size_t)row * 64 + cw + 4) = v1;
                    float s = (v0[0] * v0[0] + v0[1] * v0[1]) + (v0[2] * v0[2] + v0[3] * v0[3]) + (v1[0] * v1[0] + v1[1] * v1[1]) + (v1[2] * v1[2] + v1[3] * v1[3]);
                    s = sum_fq(s);
                    if (fq == 0) atomicAdd(ssqkr + row, s);
                )
            }
        } else {
            const bool isq = t >= 3; bf16_t* base = isq ? QL : Cb; float* ssq = isq ? ssqq : ssqc; const int col0 = (isq ? t - 3 : t) * 256 + cw;
            EPI_ROWS(
                float s = 0.f; const float rx = 1.0f / sqrtf(ssqx[row] * (1.0f / DM) + EPS);
                _Pragma("unroll") for (int bj = 0; bj < 2; ++bj) { const f32x4 v0 = acc[ai][bj][m][0] * rx, v1 = acc[ai][bj][m][1] * rx;
                    s += (v0[0] * v0[0] + v0[1] * v0[1]) + (v0[2] * v0[2] + v0[3] * v0[3]) + (v1[0] * v1[0] + v1[1] * v1[1]) + (v1[2] * v1[2] + v1[3] * v1[3]);
                    *(u32x4*)(base + (size_t)row * 512 + col0 + bj * 128) = pack8(v0, v1); }
                s = sum_fq(s);
                if (fq == 0) atomicAdd(ssq + row, s);
            )
        }
    }
};
struct EpiKVb {
    static constexpr bool PERM = true, AFTER_DRAIN = false, ALIGN = true;
    bf16_t* K; bf16_t* V; const float* ssqc; const float* ssqkr; const float* KR; const float* gk; const float* cs; const float* sn; LAS float* xch;
    __device__ __forceinline__ void operator()(AccT acc, const pg8::Unit& u, int wr, int wc, int fr, int fq) const {
        const int cw = wc * 32 + fq * 8;
        float rc[2][4];
#pragma unroll
        for (int ai = 0; ai < 2; ++ai)
#pragma unroll
            for (int m = 0; m < 4; ++m) { const int rt = ai * 128 + wr * 64 + m * 16 + fr, row = u.pm * 256 + rt;
                rc[ai][m] = 1.0f / sqrtf(ssqc[row] * (1.0f / KVL) + EPS);
                const f32x4 v0 = acc[ai][0][m][0], v1 = acc[ai][0][m][1];
                float s = (v0[0] * v0[0] + v0[1] * v0[1]) + (v0[2] * v0[2] + v0[3] * v0[3]) + (v1[0] * v1[0] + v1[1] * v1[1]) + (v1[2] * v1[2] + v1[3] * v1[3]);
                s = sum_fq(s);
                if (fq == 0) xch[rt * 4 + wc] = s * rc[ai][m] * rc[ai][m]; }
        asm volatile("s_waitcnt lgkmcnt(0)" ::: "memory"); __builtin_amdgcn_s_barrier(); asm volatile("" ::: "memory");
        const f32x4 g0 = *(const f32x4*)(gk + cw), g1 = *(const f32x4*)(gk + cw + 4);
        const int i0 = (wc * 4 + fq) * 2;
        const float ga0 = gk[128 + i0], ga1 = gk[129 + i0], gb0 = gk[160 + i0], gb1 = gk[161 + i0];
#pragma unroll
        for (int ai = 0; ai < 2; ++ai)
#pragma unroll
            for (int m = 0; m < 4; ++m) { const int rt = ai * 128 + wr * 64 + m * 16 + fr, row = u.pm * 256 + rt;
                const f32x4 pp = *(const LAS f32x4*)(xch + rt * 4);
                const float rk = 1.0f / sqrtf(((pp[0] + pp[1]) + (pp[2] + pp[3]) + ssqkr[row]) * (1.0f / QKH) + EPS), rcv = rc[ai][m], rn = rcv * rk;
                const size_t R = (size_t)((row >> 12) * NH + u.pn) * SEQ + (row & (SEQ - 1));
                *(u32x4*)(K + R * QKH + cw) = pack8(acc[ai][0][m][0] * rn * g0, acc[ai][0][m][1] * rn * g1);
                *(u32x4*)(V + R * VH + cw) = pack8(acc[ai][1][m][0] * rcv, acc[ai][1][m][1] * rcv);
                const float a0 = KR[(size_t)row * 64 + i0] * rk * ga0, a1 = KR[(size_t)row * 64 + i0 + 1] * rk * ga1, b0 = KR[(size_t)row * 64 + 32 + i0] * rk * gb0, b1 = KR[(size_t)row * 64 + 33 + i0] * rk * gb1;
                const float c0 = cs[(size_t)row * 32 + i0], c1 = cs[(size_t)row * 32 + i0 + 1], s0 = sn[(size_t)row * 32 + i0], s1 = sn[(size_t)row * 32 + i0 + 1];
                *(unsigned*)(K + R * QKH + 128 + i0) = pk2(a0 * c0 - b0 * s0, a1 * c1 - b1 * s1);
                *(unsigned*)(K + R * QKH + 160 + i0) = pk2(b0 * c0 + a0 * s0, b1 * c1 + a1 * s1); }
    }
};
struct EpiQb {
    static constexpr bool PERM = true, AFTER_DRAIN = false, ALIGN = true;
    bf16_t* Q; const float* ssqq;
    __device__ __forceinline__ void operator()(AccT acc, const pg8::Unit& u, int wr, int wc, int fr, int fq) const {
        const int col0 = u.pn * 256 + wc * 32 + fq * 8;
        EPI_ROWS(
            const float rinv = 1.0f / sqrtf(ssqq[row] * (1.0f / QL_) + EPS);
            _Pragma("unroll") for (int bj = 0; bj < 2; ++bj) { const int col = col0 + bj * 128, head = col / QKH, d = col - head * QKH;
                const size_t R = (size_t)((row >> 12) * NH + head) * SEQ + (row & (SEQ - 1));
                *(u32x4*)(Q + R * QKH + d) = pack8(acc[ai][bj][m][0] * rinv, acc[ai][bj][m][1] * rinv); }
        )
    }
};
#define RLX_AGENT __ATOMIC_RELAXED, __HIP_MEMORY_SCOPE_AGENT
#define XB_TMO      128
#define XB_XCNT(j)  (256  + 64 * (j))
#define XB_XSUB(j)  (1280 + 64 * (j))
#define XB_XGEN(j)  (2304 + 64 * (j))
#define XB_TOP      3328
#define XB_TOPGEN   3392
#define XCD_BAR_WORDS 3456
#define XB_SPIN_CAP (1u << 18)

__device__ __forceinline__ unsigned xb_ld(unsigned* p)              { return __hip_atomic_load(p, __ATOMIC_RELAXED, __HIP_MEMORY_SCOPE_AGENT); }
__device__ __forceinline__ unsigned xb_add(unsigned* p, unsigned v) { return __hip_atomic_fetch_add(p, v, __ATOMIC_RELAXED, __HIP_MEMORY_SCOPE_AGENT); }
__device__ __forceinline__ unsigned xb_xcc_id() { return (unsigned)__builtin_amdgcn_s_getreg((3 << 11) | 20) & 0xFu; }
#define XB_SPIN(cond, bar) do { unsigned _sp = 0; while (cond) { __builtin_amdgcn_s_sleep(1); \
    if ((++_sp & 255u) == 0u) { if (xb_ld(&(bar)[XB_TMO])) break; if (_sp > XB_SPIN_CAP) { atomicAdd(&(bar)[XB_TMO], 1u); break; } } } } while (0)

struct XcdBarrier {
    unsigned* bar; unsigned x;
    volatile LAS unsigned* st;
};

__device__ __forceinline__ XcdBarrier xcd_barrier_post(unsigned* bar, volatile LAS unsigned* st) {
    XcdBarrier b; b.bar = bar; b.x = xb_xcc_id(); b.st = st;
    if (threadIdx.x == 0) (void)xb_add(&bar[XB_XCNT(b.x)], 1u);
    return b;
}
__device__ __forceinline__ void xcd_barrier_complete(unsigned* bar, unsigned x, unsigned& nloc, unsigned& nx) {
    const unsigned G = gridDim.x * gridDim.y * gridDim.z;
    unsigned sum, cnt, mine, sp = 0u;
    for (;;) {
        sum = 0u; cnt = 0u; mine = 0u;
#pragma unroll
        for (unsigned j = 0; j < 16; ++j) { const unsigned c = xb_ld(&bar[XB_XCNT(j)]); sum += c; cnt += (c > 0u) ? 1u : 0u; mine = (j == x) ? c : mine; }
        if (sum == G) break;
        __builtin_amdgcn_s_sleep(1);
        if ((++sp & 255u) == 0u) { if (xb_ld(&bar[XB_TMO])) break; if (sp > XB_SPIN_CAP) { atomicAdd(&bar[XB_TMO], 1u); break; } }
    }
    nloc = mine > 0u ? mine : 1u; nx = cnt > 0u ? cnt : 1u;
}

__device__ __forceinline__ void xcd_barrier(const XcdBarrier& b) {
    asm volatile("s_waitcnt vmcnt(0)" ::: "memory");
    __syncthreads();
    if (threadIdx.x == 0) {
        unsigned* bar = b.bar;
        __builtin_amdgcn_s_waitcnt(0);
        unsigned nloc = b.st[0], nx = b.st[1];
        if (nloc == 0u) { xcd_barrier_complete(bar, b.x, nloc, nx); b.st[0] = nloc; b.st[1] = nx; }
        const unsigned old = xb_add(&bar[XB_XSUB(b.x)], 1u);
        const unsigned gen = old / nloc;
        if (old + 1u == (gen + 1u) * nloc) {
            __builtin_amdgcn_fence(__ATOMIC_RELEASE, "agent");
            asm volatile("s_waitcnt vmcnt(0)" ::: "memory");
            const unsigned og = xb_add(&bar[XB_TOP], 1u);
            const unsigned tg = og / nx;
            if (og + 1u == (tg + 1u) * nx) xb_add(&bar[XB_TOPGEN], 1u);
            else XB_SPIN(xb_ld(&bar[XB_TOPGEN]) == tg, bar);
            __builtin_amdgcn_fence(__ATOMIC_ACQUIRE, "agent");
            xb_add(&bar[XB_XGEN(b.x)], 1u);
            asm volatile("s_waitcnt vmcnt(0)" ::: "memory");
        } else {
            XB_SPIN(xb_ld(&bar[XB_XGEN(b.x)]) == gen, bar);
            __builtin_amdgcn_fence(__ATOMIC_ACQUIRE, "agent");
            asm volatile("s_waitcnt vmcnt(0)" ::: "memory");
        }
    }
    __syncthreads();
}
namespace att {
using f32x16 = __attribute__((ext_vector_type(16))) float;
using s16x4  = __attribute__((ext_vector_type(4))) short;
constexpr int NW = 8, QBLK = 32, KVBLK = 64;
constexpr float SCALE = 0.07216878364870322f;
constexpr float THR = 8.f;
constexpr int SHM_V = KVBLK * VH * 2, SHM_K = KVBLK * QKH * 2;
constexpr int NSLOT = 3;
constexpr int LDS_KR = 0, LDS_VR = NSLOT * SHM_K, LDS_WSF = LDS_VR + NSLOT * SHM_V, SHM_ATTN = LDS_WSF + NW * 64 * 4;
#define KSWZ(row, ch) ((row) * 384 + ((((ch) ^ (((row) >> 1) & 7))) << 4))
#define SBAR() __builtin_amdgcn_sched_barrier(0)
__device__ __forceinline__ int crow(int r, int hi) { return (r & 3) + 8 * (r >> 2) + 4 * hi; }
__device__ __forceinline__ unsigned cvtpk(float lo, float hi) { unsigned r; asm volatile("v_cvt_pk_bf16_f32 %0, %1, %2" : "=v"(r) : "v"(lo), "v"(hi)); return r; }

__device__ __forceinline__ void partialSM(f32x16& p0, f32x16& p1, float& m_reg, float& mn, float& alpha, bool visible) {
  constexpr float C = SCALE * 1.4426950408889634f;
  if (__builtin_expect(!visible, 0)) { for (int r = 0; r < 16; ++r) { p0[r] = -1e30f; p1[r] = -1e30f; } asm volatile("" : "+v"(p0), "+v"(p1)); }
  float pmax = p0[0]; for (int r = 1; r < 16; ++r) pmax = fmaxf(pmax, p0[r]); for (int r = 0; r < 16; ++r) pmax = fmaxf(pmax, p1[r]);
  { auto rr = __builtin_amdgcn_permlane32_swap(__float_as_uint(pmax), __float_as_uint(pmax), false, false);
    pmax = fmaxf(__uint_as_float(rr[0]), __uint_as_float(rr[1])); }
  if (__builtin_expect(__all(pmax - m_reg <= THR / SCALE), 1)) { mn = m_reg; alpha = 1.f; }
  else { mn = fmaxf(m_reg, pmax); alpha = __builtin_amdgcn_exp2f((m_reg - mn) * C); m_reg = mn; }
  float mnC = -mn * C;
  for (int r = 0; r < 16; ++r) { p0[r] = fmaf(p0[r], C, mnC); asm("" : "+v"(p0[r])); } for (int r = 0; r < 16; ++r) { p1[r] = fmaf(p1[r], C, mnC); asm("" : "+v"(p1[r])); }
  for (int r = 0; r < 16; ++r) p0[r] = __builtin_amdgcn_exp2f(p0[r]);
}
__device__ __forceinline__ void finishSM(f32x16& p0, f32x16& p1, float alpha, float& l_reg, bf16x8& pa0, bf16x8& pa1, bf16x8& pa2, bf16x8& pa3) {
  for (int r = 0; r < 16; ++r) p1[r] = __builtin_amdgcn_exp2f(p1[r]);
  float ps = 0; for (int r = 0; r < 16; ++r) ps += p0[r]; for (int r = 0; r < 16; ++r) ps += p1[r];
  { auto rr = __builtin_amdgcn_permlane32_swap(__float_as_uint(ps), __float_as_uint(ps), false, false);
    ps = __uint_as_float(rr[0]) + __uint_as_float(rr[1]); }
  l_reg = l_reg * alpha + ps;
#define PK4(P, BASE, OUT) do { unsigned a0 = cvtpk(P[BASE + 0], P[BASE + 1]), a1 = cvtpk(P[BASE + 2], P[BASE + 3]);   \
    unsigned b0 = cvtpk(P[BASE + 4], P[BASE + 5]), b1 = cvtpk(P[BASE + 6], P[BASE + 7]);                              \
    auto r0 = __builtin_amdgcn_permlane32_swap(a0, b0, false, false); auto r1 = __builtin_amdgcn_permlane32_swap(a1, b1, false, false); \
    u32x4 w = {r0[0], r1[0], r0[1], r1[1]}; OUT = *reinterpret_cast<bf16x8*>(&w); } while (0)
  PK4(p0, 0, pa0); PK4(p0, 8, pa1); PK4(p1, 0, pa2); PK4(p1, 8, pa3);
#undef PK4
}
__device__ __forceinline__ void qkt(f32x16& p0, f32x16& p1, const int (&ka)[4], int slot_off, const bf16x8* qr) {
  constexpr int PD = 2;
  bf16x8 kf0[12], kf1[12]; int kb[4];
#pragma unroll
  for (int jj = 0; jj < 4; ++jj) kb[jj] = ka[jj] + slot_off;
  p0 = f32x16{}; p1 = f32x16{};
#define QK_ISSUE(s) do { \
    asm volatile("ds_read_b128 %0, %1 offset:%c2" : "=v"(kf0[s]) : "v"(kb[(s) & 3]), "i"(((s) >> 2) * 128) : "memory"); \
    asm volatile("ds_read_b128 %0, %1 offset:%c2" : "=v"(kf1[s]) : "v"(kb[(s) & 3]), "i"(((s) >> 2) * 128 + 12288) : "memory"); } while (0)
#pragma unroll
  for (int s = 0; s < PD; ++s) QK_ISSUE(s);
#pragma unroll
  for (int d0 = 0; d0 < 12; ++d0) {
    if (d0 + PD < 12) QK_ISSUE(d0 + PD);
    const int later = 2 * ((d0 + PD < 12 ? d0 + PD : 11) - d0);
    asm volatile("s_waitcnt lgkmcnt(%c2)" : "+v"(kf0[d0]), "+v"(kf1[d0]) : "i"(later));
    p0 = __builtin_amdgcn_mfma_f32_32x32x16_bf16(kf0[d0], qr[d0], p0, 0, 0, 0);
    p1 = __builtin_amdgcn_mfma_f32_32x32x16_bf16(kf1[d0], qr[d0], p1, 0, 0, 0);
  }
#undef QK_ISSUE
}
__device__ __forceinline__ void glds16(const void* gsrc, unsigned lds_dst) { unsigned keep;
  asm volatile("s_mov_b32 %0, m0\n\ts_mov_b32 m0, %2\n\ts_nop 0\n\tglobal_load_lds_dwordx4 %1, off\n\ts_mov_b32 m0, %0" : "=&s"(keep) : "v"(gsrc), "s"(lds_dst) : "memory"); }
__device__ __forceinline__ int v_st(int k, int c) { const int kk = (k & ~0xC) | ((k & 4) << 1) | ((k & 8) >> 1); return ((kk >> 3) * 4 + (c >> 5)) * 512 + ((kk & 7) * 32 + (c & 31)) * 2; }
__device__ __forceinline__ int v_rd_base(int lane) { return ((lane & 3) << 3) | (((lane >> 2) & 3) << 6) | (((lane >> 4) & 1) << 5) | (((lane >> 5) & 1) << 8); }
constexpr int v_rd_off(int d0, int ks, int half) { return d0 * 512 + ks * 4096 + half * 2048; }
template <int OFF> __device__ __forceinline__ s16x4 tr_read(int vb) {
  s16x4 r; asm volatile("ds_read_b64_tr_b16 %0, %1 offset:%2" : "=&v"(r) : "v"(vb), "i"(OFF) : "memory"); return r;
}
template <int KS> __device__ __forceinline__ void pv_ks(f32x16* o, int vb, bf16x8 pa) {
  const s16x4 l0 = tr_read<v_rd_off(0, KS, 0)>(vb), h0 = tr_read<v_rd_off(0, KS, 1)>(vb), l1 = tr_read<v_rd_off(1, KS, 0)>(vb), h1 = tr_read<v_rd_off(1, KS, 1)>(vb);
  const s16x4 l2 = tr_read<v_rd_off(2, KS, 0)>(vb), h2 = tr_read<v_rd_off(2, KS, 1)>(vb), l3 = tr_read<v_rd_off(3, KS, 0)>(vb), h3 = tr_read<v_rd_off(3, KS, 1)>(vb);
  asm volatile("s_waitcnt lgkmcnt(0)" ::: "memory"); SBAR();
#define PK(L, H) (bf16x8){L[0], L[1], L[2], L[3], H[0], H[1], H[2], H[3]}
  o[0] = __builtin_amdgcn_mfma_f32_32x32x16_bf16(pa, PK(l0, h0), o[0], 0, 0, 0);
  o[1] = __builtin_amdgcn_mfma_f32_32x32x16_bf16(pa, PK(l1, h1), o[1], 0, 0, 0);
  o[2] = __builtin_amdgcn_mfma_f32_32x32x16_bf16(pa, PK(l2, h2), o[2], 0, 0, 0);
  o[3] = __builtin_amdgcn_mfma_f32_32x32x16_bf16(pa, PK(l3, h3), o[3], 0, 0, 0);
#undef PK
}
__device__ __forceinline__ void pv_d0(f32x16* o, int vb, bf16x8 pa0, bf16x8 pa1, bf16x8 pa2, bf16x8 pa3) {
  pv_ks<0>(o, vb, pa0); pv_ks<1>(o, vb, pa1); pv_ks<2>(o, vb, pa2); pv_ks<3>(o, vb, pa3);
}

__device__ __forceinline__ void attn_unit(const bf16_t* __restrict__ Qh, const bf16_t* __restrict__ Kh, const bf16_t* __restrict__ Vh,
                                          const bf16_t* Gt, bf16_t* Ot  , int qb, char* lds,
                                          const float* __restrict__ gq, const float* __restrict__ cs_b, const float* __restrict__ sn_b) {
  int tid_l = threadIdx.x; asm volatile("" : "+v"(tid_l));
  const int tid = tid_l, wid = __builtin_amdgcn_readfirstlane(tid >> 6), lane = tid & 63, r32 = lane & 31, hi = lane >> 5;
  const unsigned lds0 = (unsigned)(uintptr_t)lds;
  float* ws = (float*)(lds + LDS_WSF) + wid * 64; float* li_l = ws; float* al_l = ws + 32;
  float m_reg = -1e30f, l_reg = 0; f32x16 o[4] = {}; bf16x8 qr[12];
  const int q0 = qb * 256;
  const bf16_t* Qw = Qh + (size_t)(q0 + wid * QBLK + r32) * QKH + hi * 8;
  int gko[3], gvo[2];
#pragma unroll
  for (int i = 0; i < 3; ++i) { const int q = (i * 8 + wid) * 64 + lane, row = q / 24, chs = q - row * 24, ch = chs ^ ((row >> 1) & 7); gko[i] = row * QKH + ch * 8; }
#pragma unroll
  for (int i = 0; i < 2; ++i) { const int q = (i * 8 + wid) * 64 + lane, st = q >> 5, kk = (st >> 2) * 8 + ((q & 31) >> 2), cc = (st & 3) * 32 + (q & 3) * 8;
    const int k = (kk & ~0xC) | ((kk & 4) << 1) | ((kk & 8) >> 1); gvo[i] = k * VH + cc; }
#define DMA_K(t, slot) do { _Pragma("unroll") for (int i_ = 0; i_ < 3; ++i_) glds16(Kh + (size_t)(t) * (KVBLK * QKH) + gko[i_], (unsigned)__builtin_amdgcn_readfirstlane(lds0 + LDS_KR + (slot) * SHM_K + (i_ * 8 + wid) * 1024)); } while (0)
#define DMA_V(t, slot) do { _Pragma("unroll") for (int i_ = 0; i_ < 2; ++i_) glds16(Vh + (size_t)(t) * (KVBLK * VH) + gvo[i_], (unsigned)__builtin_amdgcn_readfirstlane(lds0 + LDS_VR + (slot) * SHM_V + (i_ * 8 + wid) * 1024)); } while (0)
#define WAITBAR(N) asm volatile("s_waitcnt vmcnt(" #N ") lgkmcnt(0)\n\ts_barrier" ::: "memory")
  DMA_K(0, 0); DMA_V(0, 0); DMA_K(1, 1);
  {
    float xq[12][8]; float ss = 0.f;
#pragma unroll
    for (int d0 = 0; d0 < 12; ++d0) { const u32x4 w = *reinterpret_cast<const u32x4*>(Qw + d0 * 16);
      xq[d0][0] = bflo(w.x); xq[d0][1] = bfhi(w.x); xq[d0][2] = bflo(w.y); xq[d0][3] = bfhi(w.y); xq[d0][4] = bflo(w.z); xq[d0][5] = bfhi(w.z); xq[d0][6] = bflo(w.w); xq[d0][7] = bfhi(w.w);
#pragma unroll
      for (int k = 0; k < 8; ++k) ss += xq[d0][k] * xq[d0][k]; }
    { auto rr = __builtin_amdgcn_permlane32_swap(__float_as_uint(ss), __float_as_uint(ss), false, false); ss = __uint_as_float(rr[0]) + __uint_as_float(rr[1]); }
    const float rinv = 1.0f / sqrtf(ss * (1.0f / QKH) + EPS);
#pragma unroll
    for (int d0 = 0; d0 < 12; ++d0) { const f32x4 g0 = *(const f32x4*)(gq + d0 * 16 + hi * 8), g1 = *(const f32x4*)(gq + d0 * 16 + hi * 8 + 4);
#pragma unroll
      for (int k = 0; k < 4; ++k) { xq[d0][k] *= rinv * g0[k]; xq[d0][4 + k] *= rinv * g1[k]; } }
    const size_t trow = (size_t)(q0 + wid * QBLK + r32) * 32 + hi * 8;
#pragma unroll
    for (int p = 0; p < 2; ++p) { const f32x4 c0 = *(const f32x4*)(cs_b + trow + p * 16), c1 = *(const f32x4*)(cs_b + trow + p * 16 + 4), s0 = *(const f32x4*)(sn_b + trow + p * 16), s1 = *(const f32x4*)(sn_b + trow + p * 16 + 4);
#pragma unroll
      for (int k = 0; k < 8; ++k) { const float cc = k < 4 ? c0[k & 3] : c1[k & 3], sv = k < 4 ? s0[k & 3] : s1[k & 3]; const float a = xq[8 + p][k], b = xq[10 + p][k];
        xq[8 + p][k] = a * cc - b * sv; xq[10 + p][k] = b * cc + a * sv; } }
#pragma unroll
    for (int d0 = 0; d0 < 12; ++d0) { u32x4 w; w.x = cvtpk(xq[d0][0], xq[d0][1]); w.y = cvtpk(xq[d0][2], xq[d0][3]); w.z = cvtpk(xq[d0][4], xq[d0][5]); w.w = cvtpk(xq[d0][6], xq[d0][7]);
      qr[d0] = __builtin_bit_cast(bf16x8, w); }
  }
  int ka[4];
#pragma unroll
  for (int jj = 0; jj < 4; ++jj) ka[jj] = (int)(lds0 + LDS_KR) + r32 * 384 + (((2 * jj + hi) ^ ((r32 >> 1) & 7)) << 4);
  const int jmax = (q0 + wid * QBLK) >> 6;
  const int vb0 = (int)(lds0 + LDS_VR) + v_rd_base(lane);
#define RESC(a) do { if (__any((a) < 1.f)) { if (hi == 0) al_l[r32] = (a); asm volatile("s_waitcnt lgkmcnt(0)" ::: "memory"); \
    for (int d = 0; d < 4; ++d) for (int r = 0; r < 16; ++r) o[d][r] *= al_l[crow(r, hi)]; } } while (0)
  f32x16 pA0, pA1, pB0, pB1; float mnA, mnB, alA, alB; bf16x8 pa0, pa1, pa2, pa3; const int NT = (q0 + 256) / KVBLK;
  int s0 = 0, s1 = 1, s2 = 2;
#define ROT() do { const int t_ = s0; s0 = s1; s1 = s2; s2 = t_; } while (0)
  WAITBAR(0);
  DMA_K(2, s2); DMA_V(1, s1);
  qkt(pA0, pA1, ka, s0 * SHM_K, qr); partialSM(pA0, pA1, m_reg, mnA, alA, true);
  WAITBAR(5); ROT();
  for (int j = 1; j + 1 < NT; j += 2) {
    DMA_K(j + 2, s2); DMA_V(j + 1, s1);
    if (j <= jmax) { SBAR(); qkt(pB0, pB1, ka, s0 * SHM_K, qr); }
    if (j - 1 <= jmax) { finishSM(pA0, pA1, alA, l_reg, pa0, pa1, pa2, pa3); SBAR();
      pv_d0(o, vb0 + s2 * SHM_V, pa0, pa1, pa2, pa3); }
    if (j <= jmax) { partialSM(pB0, pB1, m_reg, mnB, alB, true); RESC(alB); }
    WAITBAR(5); ROT();
    const bool more = j + 3 < NT;
    if (more) DMA_K(j + 3, s2);
    DMA_V(j + 2, s1);
    if (j + 1 <= jmax) { SBAR(); qkt(pA0, pA1, ka, s0 * SHM_K, qr); }
    if (j <= jmax) { finishSM(pB0, pB1, alB, l_reg, pa0, pa1, pa2, pa3); SBAR();
      pv_d0(o, vb0 + s2 * SHM_V, pa0, pa1, pa2, pa3); }
    if (j + 1 <= jmax) { partialSM(pA0, pA1, m_reg, mnA, alA, true); RESC(alA); }
    if (more) WAITBAR(5); else WAITBAR(2);
    ROT();
  }
  if (NT - 1 <= jmax) { SBAR(); qkt(pB0, pB1, ka, s0 * SHM_K, qr); }
  if (NT - 2 <= jmax) { finishSM(pA0, pA1, alA, l_reg, pa0, pa1, pa2, pa3); SBAR();
    pv_d0(o, vb0 + s2 * SHM_V, pa0, pa1, pa2, pa3); }
  if (NT - 1 <= jmax) { partialSM(pB0, pB1, m_reg, mnB, alB, true); RESC(alB); }
  WAITBAR(0);
  if (NT - 1 <= jmax) { finishSM(pB0, pB1, alB, l_reg, pa0, pa1, pa2, pa3); SBAR();
    pv_d0(o, vb0 + s0 * SHM_V, pa0, pa1, pa2, pa3); }
  if (hi == 0) li_l[r32] = l_reg; asm volatile("s_waitcnt lgkmcnt(0)" ::: "memory");
  float rli[16];
#pragma unroll
  for (int r = 0; r < 16; ++r) rli[r] = __builtin_amdgcn_rcpf(li_l[crow(r, hi)]);
  const size_t rowb = (size_t)(q0 + wid * QBLK);
#pragma unroll
  for (int r = 0; r < 16; ++r) { const size_t off = (rowb + crow(r, hi)) * WB + r32;
#pragma unroll
    for (int d0 = 0; d0 < 4; ++d0) { const float g = __builtin_bit_cast(float, (unsigned)Gt[off + d0 * 32] << 16);
      Ot[off + d0 * 32] = (bf16_t)f2bf(o[d0][r] * rli[r] * g); } }
  asm volatile("s_waitcnt lgkmcnt(0)\n\ts_barrier" ::: "memory");
#undef DMA_K
#undef DMA_V
#undef WAITBAR
#undef RESC
#undef ROT
}
#undef SBAR
}
struct Ctx { int tid, lane, wave, gw, ngw; LAS unsigned char* lds; };

__device__ __forceinline__ void transpose_item(const float* __restrict__ W, int K, int N, int ldw, bf16_t* __restrict__ WT, int row_off, const float* __restrict__ gain, LAS float* scr, int item, int lane) {
    const int nblk = N / 32, kb = item / nblk, nb = item % nblk, k0 = 64 * kb, n0 = 32 * nb;
    float wv[32];
    const float* wp = W + (size_t)(k0 + (lane >> 5)) * ldw + n0 + (lane & 31);
#pragma unroll
    for (int i = 0; i < 32; ++i) wv[i] = wp[(size_t)(2 * i) * ldw];
    if (gain) {
#pragma unroll
        for (int i = 0; i < 32; ++i) wv[i] *= gain[k0 + 2 * i + (lane >> 5)];
    }
#pragma unroll
    for (int i = 0; i < 32; ++i) scr[(2 * i + (lane >> 5)) * 33 + (lane & 31)] = wv[i];
    asm volatile("s_waitcnt lgkmcnt(0)" ::: "memory");
    const int c = lane & 7;
#pragma unroll
    for (int j = 0; j < 4; ++j) { const int n = (lane >> 3) + 8 * j; const LAS float* s = scr + (8 * c) * 33 + n;
        u32x4 o; o.x = pk2(s[0 * 33], s[1 * 33]); o.y = pk2(s[2 * 33], s[3 * 33]); o.z = pk2(s[4 * 33], s[5 * 33]); o.w = pk2(s[6 * 33], s[7 * 33]);
        *(u32x4*)(WT + (size_t)(row_off + n0 + n) * K + k0 + 8 * c) = o; }
    asm volatile("s_waitcnt lgkmcnt(0)" ::: "memory");
}
__device__ __forceinline__ void convert_weight(const Ctx& c, const float* W, int K, int N, bf16_t* WT, int row_off, const float* gain, int ldw = 0) {
    LAS float* scr = (LAS float*)(c.lds + c.wave * 16384);
    const int nitems = (K / 64) * (N / 32);
    for (int it = c.gw; it < nitems; it += c.ngw) transpose_item(W, K, N, ldw ? ldw : N, WT, row_off, gain, scr, it, c.lane);
}
__device__ __forceinline__ void convert_plain(const Ctx& c, const float* __restrict__ W, int K, int ncols, int ldw, bf16_t* __restrict__ out, int ldo, int coff, const float* __restrict__ gain) {
    const int per_row = ncols / 8, total = K * per_row, stride = c.ngw * 64;
    for (int i0 = c.gw * 64 + c.lane; i0 < total; i0 += 4 * stride) {
        f32x4 a[4], b[4]; int kk[4], cc[4];
#pragma unroll
        for (int u = 0; u < 4; ++u) { const int i = i0 + u * stride; const bool ok = i < total; const int ii = ok ? i : i0; kk[u] = ii / per_row; cc[u] = (ii - kk[u] * per_row) * 8;
            a[u] = *(const f32x4*)(W + (size_t)kk[u] * ldw + cc[u]); b[u] = *(const f32x4*)(W + (size_t)kk[u] * ldw + cc[u] + 4); }
#pragma unroll
        for (int u = 0; u < 4; ++u) { if (i0 + u * stride < total) { const float g = gain[kk[u]]; *(u32x4*)(out + (size_t)kk[u] * ldo + coff + cc[u]) = pack8(a[u] * g, b[u] * g); } }
    }
}
__device__ __forceinline__ void xprep_rows(const Ctx& c, const float* __restrict__ x, bf16_t* __restrict__ xb, float* __restrict__ ssq) {
    for (int r = c.gw; r < MTOK; r += c.ngw) {
        const f32x4* xr = (const f32x4*)(x + (size_t)r * DM) + c.lane;
        f32x4 v[8]; float s = 0.f;
#pragma unroll
        for (int j = 0; j < 8; ++j) { v[j] = xr[64 * j]; s += (v[j].x * v[j].x + v[j].y * v[j].y) + (v[j].z * v[j].z + v[j].w * v[j].w); }
        s = wave_sum(s);
        if (c.lane == 0) ssq[r] = s;
        u32x2* o = (u32x2*)(xb + (size_t)r * DM) + c.lane;
#pragma unroll
        for (int j = 0; j < 8; ++j) { u32x2 w; w.x = pk2(v[j].x, v[j].y); w.y = pk2(v[j].z, v[j].w); o[64 * j] = w; }
    }
}
__device__ __forceinline__ void rope_tables(const Ctx& c, const int* __restrict__ pos, float* __restrict__ cs, float* __restrict__ sn) {
    const int gt = c.gw * 64 + c.lane, ngt = c.ngw * 64;
    for (int i = gt; i < MTOK * 32; i += ngt) {
        const int t = i >> 5, f = i & 31;
        const float inv = exp2f(-(float)f * 0.41524101186092029f);
        const float ang = (float)pos[t] * inv;
        float sd, cd; sincosf(ang, &sd, &cd);
        cs[i] = cd; sn[i] = sd;
    }
}
__device__ __forceinline__ void load8(const bf16_t* p, float* f) { const u32x4 w = *(const u32x4*)p; f[0] = bflo(w.x); f[1] = bfhi(w.x); f[2] = bflo(w.y); f[3] = bfhi(w.y); f[4] = bflo(w.z); f[5] = bfhi(w.z); f[6] = bflo(w.w); f[7] = bfhi(w.w); }
__device__ __forceinline__ void pool_phase(const Ctx& c, const bf16_t* __restrict__ U, bf16_t* __restrict__ P, const bf16_t* __restrict__ G, const float* __restrict__ scale) {
    constexpr int SEGL = 64, NSEG = MTOK / SEGL;
    for (int seg = blockIdx.x; seg < NSEG; seg += gridDim.x) {
        const int t0 = seg * SEGL, s0 = t0 & (SEQ - 1), col = c.tid * 8, w = 2 << (col >> 10);
        const bf16_t* Uc = U + col; bf16_t* Pc = P + col; const bf16_t* Gc = G + col;
        float sc[8];
#pragma unroll
        for (int k = 0; k < 8; ++k) sc[k] = scale[col + k];
        float sum[8];
#pragma unroll
        for (int k = 0; k < 8; ++k) sum[k] = 0.f;
        for (int i = 1; i <= w; ++i) { if (s0 - i >= 0) { float f[8]; load8(Uc + (size_t)(t0 - i) * WA, f);
#pragma unroll
            for (int k = 0; k < 8; ++k) sum[k] += f[k]; } }
        const float rw = 1.0f / (float)w;
#pragma unroll 4
        for (int i = 0; i < SEGL; ++i) {
            const int t = t0 + i, s = s0 + i; float f[8], old[8];
            load8(Uc + (size_t)t * WA, f);
            if (s >= w) load8(Uc + (size_t)(t - w) * WA, old); else {
#pragma unroll
                for (int k = 0; k < 8; ++k) old[k] = 0.f; }
            const float rc = (s + 1 < w) ? 1.0f / (float)(s + 1) : rw;
            float o[8], gt[8]; load8(Gc + (size_t)t * WA, gt);
#pragma unroll
            for (int k = 0; k < 8; ++k) { sum[k] += f[k] - old[k]; o[k] = (sum[k] * rc - f[k]) * sc[k] * gt[k]; }
            u32x4 pw; pw.x = pk2(o[0], o[1]); pw.y = pk2(o[2], o[3]); pw.z = pk2(o[4], o[5]); pw.w = pk2(o[6], o[7]);
            *(u32x4*)(Pc + (size_t)t * WA) = pw;
        }
    }
}
template <bool ISK>
__device__ __forceinline__ void qknorm_rope(const Ctx& c, bf16_t* __restrict__ T, const float* __restrict__ KR, const float* __restrict__ g, const float* __restrict__ cs, const float* __restrict__ sn) {
    const int l = c.lane & 7, sub = c.lane >> 3;
    float gn[16], g1[4], g2[4];
#pragma unroll
    for (int k = 0; k < 16; ++k) gn[k] = g[16 * l + k];
#pragma unroll
    for (int k = 0; k < 4; ++k) { g1[k] = g[128 + 4 * l + k]; g2[k] = g[160 + 4 * l + k]; }
    const int nvec = MTOK * NH;
    for (int v = c.gw * 8 + sub; v < nvec; v += c.ngw * 8) {
        const int s = v & (SEQ - 1), bh = v >> 12, tok = (bh >> 4) * SEQ + s;
        bf16_t* p = T + (size_t)v * QKH;
        float x[16], t1[4], t2[4];
        load8(p + 16 * l, x); load8(p + 16 * l + 8, x + 8);
        if (ISK) { const f32x4 a = *(const f32x4*)(KR + (size_t)tok * 64 + 4 * l), b = *(const f32x4*)(KR + (size_t)tok * 64 + 32 + 4 * l);
#pragma unroll
            for (int k = 0; k < 4; ++k) { t1[k] = a[k]; t2[k] = b[k]; } }
        else { const u32x2 a = *(const u32x2*)(p + 128 + 4 * l), b = *(const u32x2*)(p + 160 + 4 * l);
            t1[0] = bflo(a.x); t1[1] = bfhi(a.x); t1[2] = bflo(a.y); t1[3] = bfhi(a.y); t2[0] = bflo(b.x); t2[1] = bfhi(b.x); t2[2] = bflo(b.y); t2[3] = bfhi(b.y); }
        float ss = 0.f;
#pragma unroll
        for (int k = 0; k < 16; ++k) ss += x[k] * x[k];
#pragma unroll
        for (int k = 0; k < 4; ++k) ss += t1[k] * t1[k] + t2[k] * t2[k];
        ss += __shfl_xor(ss, 1); ss += __shfl_xor(ss, 2); ss += __shfl_xor(ss, 4);
        const float rinv = 1.0f / sqrtf(ss * (1.0f / QKH) + EPS);
        const f32x4 cc = *(const f32x4*)(cs + (size_t)tok * 32 + 4 * l), sv = *(const f32x4*)(sn + (size_t)tok * 32 + 4 * l);
        u32x4 w0, w1;
#pragma unroll
        for (int k = 0; k < 16; ++k) x[k] *= rinv * gn[k];
        w0.x = pk2(x[0], x[1]); w0.y = pk2(x[2], x[3]); w0.z = pk2(x[4], x[5]); w0.w = pk2(x[6], x[7]);
        w1.x = pk2(x[8], x[9]); w1.y = pk2(x[10], x[11]); w1.z = pk2(x[12], x[13]); w1.w = pk2(x[14], x[15]);
        float o1[4], o2[4];
#pragma unroll
        for (int k = 0; k < 4; ++k) { const float a = t1[k] * rinv * g1[k], b = t2[k] * rinv * g2[k]; o1[k] = a * cc[k] - b * sv[k]; o2[k] = b * cc[k] + a * sv[k]; }
        *(u32x4*)(p + 16 * l) = w0; *(u32x4*)(p + 16 * l + 8) = w1;
        u32x2 r1, r2; r1.x = pk2(o1[0], o1[1]); r1.y = pk2(o1[2], o1[3]); r2.x = pk2(o2[0], o2[1]); r2.y = pk2(o2[2], o2[3]);
        *(u32x2*)(p + 128 + 4 * l) = r1; *(u32x2*)(p + 160 + 4 * l) = r2;
    }
}
struct Args { const void* in[18]; float* out; unsigned char* ws; };
enum { I_X = 0, I_POS, I_ANG, I_AWIN, I_AWG, I_ASC, I_AWOUT, I_KVNG, I_KVWA, I_KVLG, I_KVWB, I_KNG, I_BNG, I_BWIN, I_BQLG, I_BWQB, I_BQNG, I_BWOUT };

#define GEMM_RUN_M(EPI, M_, gA, gB, N_, K_, LDA, LDB, AGD, AGS, BGD, BGS, ...) do { \
    pg8::Gemm g_{(const bf16_t*)(gA), (const bf16_t*)(gB), (M_), (N_), (K_), (LDA), (LDB), (AGD), (AGS), (BGD), (BGS)}; pg8::StaticOrder S_; S_.init((M_), (N_), (int)gridDim.x, (int)blockIdx.x); \
    EPI E_{__VA_ARGS__}; pg8::gemm_phase<EPI, pg8::StaticOrder, EPI::ALIGN, true>(c.lds, g_, S_, E_); } while (0)
#define GEMM_RUN(EPI, gA, gB, N_, K_, LDA, LDB, AGD, AGS, ...) GEMM_RUN_M(EPI, MTOK, gA, gB, N_, K_, LDA, LDB, AGD, AGS, NOGRP, 0, __VA_ARGS__)
constexpr int NOGRP = 1 << 30;

typedef const __attribute__((address_space(4))) Args* ArgsP;
__device__ __forceinline__ ArgsP get_args() { auto p = __builtin_amdgcn_kernarg_segment_ptr(); asm volatile("" : "+s"(p)); return (ArgsP)p; }
__device__ __forceinline__ Ctx make_ctx(unsigned char* lds_raw) {
    Ctx c; int tid = threadIdx.x; asm volatile("" : "+v"(tid)); c.tid = tid; c.lane = tid & 63; c.wave = __builtin_amdgcn_readfirstlane(tid >> 6); c.gw = blockIdx.x * 8 + c.wave; c.ngw = gridDim.x * 8; c.lds = (LAS unsigned char*)lds_raw; return c;
}
#define PHASE_BEGIN ArgsP ap = get_args(); unsigned char* ws = ap->ws; const Ctx c = make_ctx(lds_raw); (void)ws; (void)c;
#define INF(k) ((const float*)ap->in[k])
#define WSB(off) ((bf16_t*)(ws + (off)))
#define WSF(off) ((float*)(ws + (off)))

#define GRID_BAR() do { ArgsP ap_ = get_args(); XcdBarrier b_; b_.bar = (unsigned*)(ap_->ws + WS_BAR); b_.x = xb_xcc_id(); b_.st = (volatile LAS unsigned*)((LAS unsigned char*)lds_raw + MISC_OFF); xcd_barrier(b_); } while (0)

__global__ void __launch_bounds__(512, 2) yoco_fwd(Args a_unused) {
    extern __shared__ __attribute__((aligned(16))) unsigned char lds_raw[];
    cg::grid_group grid = cg::this_grid();
    if (threadIdx.x < 2) ((LAS unsigned*)((LAS unsigned char*)lds_raw + MISC_OFF))[threadIdx.x] = 0u;
    { ArgsP ap_ = get_args(); if (threadIdx.x == 0) (void)xb_add((unsigned*)(ap_->ws + WS_BAR) + XB_XCNT(xb_xcc_id()), 1u); }
    __syncthreads();

    {
        PHASE_BEGIN
        rope_tables(c, (const int*)ap->in[I_POS], WSF(WS_COS), WSF(WS_SIN));
        { float* z = WSF(WS_SSQC); for (int i = c.gw * 64 + c.lane; i < 3 * MTOK; i += c.ngw * 64) z[i] = 0.f; }
        { float* z = WSF(WS_SSQX) + MTOK; for (int i = c.gw * 64 + c.lane; i < 4 * MTOK; i += c.ngw * 64) z[i] = 0.f; }
        xprep_rows(c, INF(I_X), (bf16_t*)ap->out, WSF(WS_SSQX));
#pragma unroll 1
        for (int l = 0; l < 2; ++l) {
            const float* win = INF(I_AWIN) + (size_t)l * DM * 2 * WA; const float* gl = INF(I_ANG) + l * DM;
#pragma unroll 1
            for (int g = 0; g < 4; ++g) convert_weight(c, INF(I_AWG) + ((size_t)l * 4 + g) * GA * GA, GA, GA, WSB(WS_AWGB), l * WA + g * GA, nullptr);
            convert_plain(c, win, DM, WA, 2 * WA, WSB(WS_WINUB), 2 * WA, l * WA, gl);
            convert_weight(c, win + WA, DM, WA, WSB(l ? WS_A1WIN : WS_AWIN), WA, gl, 2 * WA);
            convert_weight(c, INF(I_AWOUT) + (size_t)l * WA * DM, WA, DM, WSB(l ? WS_A1WOUT : WS_AWOUT), 0, nullptr);
        }
    }
    if (gridDim.x == 0x7fffffffu) grid.sync();
    GRID_BAR();
    {
        PHASE_BEGIN
        GEMM_RUN_M(EpiWp, 2 * WA, WSB(WS_AWGB), WSB(WS_WINUB), DM, GA, GA, 2 * WA, NOGRP, 0, 4, GA, WSB(WS_AWIN), WSB(WS_A1WIN));
    }
    GRID_BAR();
#pragma unroll 1
    for (int l = 0; l < 2; ++l) {
        {
            PHASE_BEGIN
            GEMM_RUN(EpiA1, (bf16_t*)ap->out + (size_t)l * MTOK * DM, WSB(l ? WS_A1WIN : WS_AWIN), 2 * WA, DM, DM, DM, NOGRP, 0, WSB(l ? WS_R0 : WS_R1), WSB(WS_G), WSF(WS_SSQX) + l * MTOK);
        }
        GRID_BAR();
        {
            PHASE_BEGIN
            pool_phase(c, WSB(l ? WS_R0 : WS_R1), WSB(l ? WS_R1 : WS_R0), WSB(WS_G), INF(I_ASC) + l * WA);
            if (l == 1) {
                bf16_t* WC0 = WSB(WS_BWC0);
                convert_weight(c, INF(I_KVWA), DM, KVL + QKR, WC0, 0, INF(I_KVNG));
                { u32x4* z = (u32x4*)(WC0 + (size_t)(KVL + QKR) * DM); const int n16 = 192 * DM * 2 / 16; for (int i = c.gw * 64 + c.lane; i < n16; i += c.ngw * 64) z[i] = (u32x4){0u, 0u, 0u, 0u}; }
                convert_weight(c, INF(I_BWIN), DM, QL_ + WB, WC0, 768, INF(I_BNG));
            }
        }
        GRID_BAR();
        {
            PHASE_BEGIN
            GEMM_RUN(EpiRes, WSB(l ? WS_R1 : WS_R0), WSB(l ? WS_A1WOUT : WS_AWOUT), DM, WA, WA, WA, NOGRP, 0, (const bf16_t*)ap->out + (size_t)l * MTOK * DM, (float*)nullptr, (bf16_t*)ap->out + (size_t)(1 - l) * MTOK * DM, WSF(WS_SSQX) + (l + 1) * MTOK);
        }
        GRID_BAR();
    }
#pragma unroll 1
    for (int j = 0; j < 2; ++j) {
        {
            PHASE_BEGIN
            float* ssqq = WSF(j ? WS_SSQQ1 : WS_SSQQ0);
            GEMM_RUN(EpiBin, (j ? WSB(WS_XB2) : (bf16_t*)ap->out), WSB(j ? WS_BWIN1 : WS_BWC0), j ? 2560 : 3328, DM, DM, DM, NOGRP, 0, WSB(WS_CB), WSB(WS_QL), WSB(WS_GB), WSF(WS_KR), WSF(WS_SSQC), ssqq, j ? 3 : 0, WSF(WS_SSQX) + (2 + j) * MTOK, WSF(WS_SSQKR));
        }
        {
            PHASE_BEGIN
            if (j == 0) {
                const int G_ = gridDim.x, nfull = (G_ == 256) ? 64 : 0;
                if ((int)blockIdx.x >= nfull) {
                    Ctx c2 = c; c2.gw = ((int)blockIdx.x - nfull) * 8 + c.wave; c2.ngw = (G_ - nfull) * 8;
                    convert_weight(c2, INF(I_BWIN) + (size_t)DM * (QL_ + WB), DM, QL_ + WB, WSB(WS_BWIN1), 0, INF(I_BNG) + DM);
                    convert_weight(c2, INF(I_KVWB), KVL, NH * (QKN + VH), WSB(WS_BWKVB), 0, INF(I_KVLG));
#pragma unroll 1
                    for (int jj = 0; jj < 2; ++jj) {
                        convert_weight(c2, INF(I_BWQB) + (size_t)jj * QL_ * NH * QKH, QL_, NH * QKH, WSB(jj ? WS_BWQB1 : WS_BWQB0), 0, INF(I_BQLG) + jj * QL_);
                        convert_weight(c2, INF(I_BWOUT) + (size_t)jj * WB * DM, WB, DM, WSB(jj ? WS_BWO1 : WS_BWO0), 0, nullptr);
                    }
                }
            }
        }
        GRID_BAR();
        if (j == 0) {
            PHASE_BEGIN
            GEMM_RUN(EpiKVb, WSB(WS_CB), WSB(WS_BWKVB), NH * (QKN + VH), KVL, KVL, KVL, NOGRP, 0, WSB(WS_K), WSB(WS_V), WSF(WS_SSQC), WSF(WS_SSQKR), WSF(WS_KR), INF(I_KNG), WSF(WS_COS), WSF(WS_SIN), (LAS float*)(c.lds + XCH_OFF));
        }
        {
            PHASE_BEGIN
            GEMM_RUN(EpiQb, WSB(WS_QL), WSB(j ? WS_BWQB1 : WS_BWQB0), NH * QKH, QL_, QL_, QL_, NOGRP, 0, WSB(WS_Q), WSF(j ? WS_SSQQ1 : WS_SSQQ0));
        }
        GRID_BAR();
        {
            PHASE_BEGIN
            const int G_ = gridDim.x, bx = blockIdx.x; const int vcu = (G_ % 8 == 0) ? (bx % 8) * (G_ / 8) + bx / 8 : bx;
#pragma unroll 1
            for (int slot = vcu; slot < 256; slot += G_) {
                const int bh = slot >> 2, s = slot & 3, b = bh >> 4, h = bh & 15;
#pragma unroll 1
                for (int i = 0; i < 4; ++i) {
                    const int qb = (i == 0) ? 15 - s : (i == 1) ? 8 + s : (i == 2) ? 7 - s : s;
                    att::attn_unit(WSB(WS_Q) + (size_t)bh * SEQ * QKH, WSB(WS_K) + (size_t)bh * SEQ * QKH, WSB(WS_V) + (size_t)bh * SEQ * VH,
                                   WSB(WS_GB) + (size_t)b * SEQ * WB + h * VH, WSB(WS_OG) + (size_t)b * SEQ * WB + h * VH, qb, (char*)lds_raw,
                                   INF(I_BQNG) + j * QKH, WSF(WS_COS) + (size_t)b * SEQ * 32, WSF(WS_SIN) + (size_t)b * SEQ * 32);
                }
            }
        }
        GRID_BAR();
        {
            PHASE_BEGIN
            GEMM_RUN(EpiRes, WSB(WS_OG), WSB(j ? WS_BWO1 : WS_BWO0), DM, WB, WB, WB, NOGRP, 0, (j ? (const bf16_t*)WSB(WS_XB2) : (const bf16_t*)ap->out), (j ? ap->out : (float*)nullptr), (j == 0 ? WSB(WS_XB2) : (bf16_t*)nullptr), WSF(WS_SSQX) + 3 * MTOK);
        }
        if (j == 0) GRID_BAR();
    }
}

extern "C" void kernel_launch(void* const* d_in, const int* in_sizes, int n_in, void* d_out, int out_size, void* d_ws, size_t ws_size, hipStream_t stream) {
    static int grid_blocks = 0;
    if (grid_blocks == 0) {
        if (n_in != 18 || out_size != MTOK * DM || ws_size < WS_END) { fprintf(stderr, "kernel_launch: unexpected shapes n_in %d out %d ws %zu (need %zu)\n", n_in, out_size, ws_size, (size_t)WS_END); grid_blocks = -1; return; }
        int dev = 0, cus = 0, per_cu = 0;
        (void)hipGetDevice(&dev); (void)hipDeviceGetAttribute(&cus, hipDeviceAttributeMultiprocessorCount, dev);
        if (hipFuncSetAttribute((const void*)yoco_fwd, hipFuncAttributeMaxDynamicSharedMemorySize, LDS_BYTES) != hipSuccess) { fprintf(stderr, "kernel_launch: hipFuncSetAttribute failed\n"); grid_blocks = -1; return; }
        if (hipOccupancyMaxActiveBlocksPerMultiprocessor(&per_cu, (const void*)yoco_fwd, 512, LDS_BYTES) != hipSuccess || per_cu < 1) { fprintf(stderr, "kernel_launch: occupancy query gave %d\n", per_cu); per_cu = 1; }
        (void)hipGetLastError();
        grid_blocks = cus * 1;
        fprintf(stderr, "kernel_launch: cus %d per_cu %d grid %d ws %zu\n", cus, per_cu, grid_blocks, ws_size);
    }
    if (grid_blocks < 0) return;
    if (hipMemsetAsync((char*)d_ws + WS_BAR, 0, XCD_BAR_WORDS * 4, stream) != hipSuccess) { fprintf(stderr, "kernel_launch: hipMemsetAsync failed\n"); return; }
    Args a{};
    for (int i = 0; i < 18; ++i) a.in[i] = d_in[i];
    a.out = (float*)d_out; a.ws = (unsigned char*)d_ws;
    void* args[] = {&a};
    hipError_t e = hipLaunchCooperativeKernel((const void*)yoco_fwd, dim3(grid_blocks), dim3(512), args, LDS_BYTES, stream);
    if (e != hipSuccess) fprintf(stderr, "cooperative launch failed: %s (grid %d)\n", hipGetErrorString(e), grid_blocks);
}
```

```cpp
#include <hip/hip_runtime.h>
#include <hip/hip_cooperative_groups.h>
#include <hip/hip_bf16.h>
#include <cstdio>
#include <cstdint>
namespace cg = cooperative_groups;

namespace pg8 {
#define PG8_LAS __attribute__((address_space(3)))
typedef unsigned short bf16_t;
typedef short bf16x8 __attribute__((ext_vector_type(8)));
typedef float f32x4 __attribute__((ext_vector_type(4)));
typedef unsigned u32x4 __attribute__((ext_vector_type(4)));
constexpr int BM = 256, BK = 64, HALF = 128, HTB = HALF * BK * 2  , STAGE_BYTES = 8 * HTB, NXCD = 8, WGM = 8;

__host__ __device__ __forceinline__ int lds_byte(int r, int c) { const int st = (r >> 4) * 2 + (c >> 5), rr = r & 15, cc = c & 31, ob = rr * 64 + cc * 2; return st * 1024 + (ob ^ (((ob >> 9) & 1) << 5)); }
__host__ __device__ __forceinline__ void stage_rc(int b, int& R, int& C) { const int st = b / 1024, sb = b % 1024, swz = sb ^ (((sb >> 9) & 1) << 5); R = (st >> 1) * 16 + swz / 64; C = (st & 1) * 32 + (swz % 64) / 2; }
__host__ __device__ __forceinline__ int perm32(int rho) { const int n = rho >> 4, i = rho & 15; return 8 * (i >> 2) + 4 * n + (i & 3); }

struct Unit { int pm, pn; };
struct Gemm { const bf16_t* A; const bf16_t* Bt; int M, N, K, lda, ldb, agdiv, agstep, bgdiv, bgstep; };

struct StaticOrder {
    int nM, nN, nwg, G, c;
    __host__ __device__ void init(int M, int N, int G_, int c_) { nM = M / BM; nN = N / BM; nwg = nM * nN; G = G_; c = c_; }
    __host__ __device__ bool next(int i, Unit& u) const {
        const long L = (long)i * G + c; if (L >= nwg) return false;
        int wgid = (int)L; { const int q = nwg / NXCD, r = nwg % NXCD, xcd = wgid % NXCD, off = wgid / NXCD; wgid = (xcd < r ? xcd * (q + 1) : r * (q + 1) + (xcd - r) * q) + off; }
        const int nig = WGM * nN, gid = wgid / nig, fm = gid * WGM, gsz = (nM - fm) < WGM ? (nM - fm) : WGM;
        u.pm = fm + ((wgid % nig) % gsz); u.pn = (wgid % nig) / gsz; return true;
    }
    __device__ __forceinline__ void a_ready(const Unit&) const {}
    __device__ __forceinline__ void done(const Unit&) const {}
};

#define PG8_UA(u) ((const char*)g.A + (size_t)(u).pm * tstepA + (size_t)((u).pn / g.agdiv) * (size_t)g.agstep * 2)
#define PG8_UB(u) ((const char*)g.Bt + (size_t)(u).pn * tstepB + (size_t)((u).pm / g.bgdiv) * (size_t)g.bgstep * 2)
template <class Epi, class Sched, bool ALIGN_EPI = false, bool SP2 = false>
__device__ __forceinline__ void gemm_phase(PG8_LAS unsigned char* lds, const Gemm g, const Sched& S, const Epi& E) {
    int tid_l = threadIdx.x; asm volatile("" : "+v"(tid_l));
    const int tid = tid_l, wid = __builtin_amdgcn_readfirstlane(tid >> 6), lane = tid & 63, wr = wid >> 2, wc = wid & 3, fr = lane & 15, fq = lane >> 4;
    const int K = g.K, nt = K / BK;
    unsigned voffA[2], voffB[2];
#pragma unroll
    for (int i = 0; i < 2; ++i) { int R, C; stage_rc(tid * 16 + i * 8192, R, C); const int Rb = Epi::PERM ? ((R & ~31) + perm32(R & 31)) : R;
        voffA[i] = (unsigned)(R * g.lda + C) * 2u; voffB[i] = (unsigned)(Rb * g.ldb + C) * 2u; }
    const size_t kstep = (size_t)(BK * 2);
    const size_t hstepA = (size_t)HALF * g.lda * 2, hstepB = (size_t)HALF * g.ldb * 2;
    const size_t tstepA = 2 * hstepA, tstepB = 2 * hstepB;
    const unsigned ldsw = (unsigned)wid * 1024u;
    const int aoff = lds_byte(wr * 64 + fr, fq * 8), boff = lds_byte(wc * 32 + fr, fq * 8);
#define PG8_SA(b, h) (((b) * 2 + (h)) * HTB)
#define PG8_SB(b, h) ((4 + (b) * 2 + (h)) * HTB)
#define PG8_STAGE(bufoff, gbase, voff) do { _Pragma("unroll") for (int _i = 0; _i < 2; ++_i) \
        __builtin_amdgcn_global_load_lds((const unsigned*)((const char*)(gbase) + (voff)[_i]), (PG8_LAS unsigned*)(lds + (bufoff) + ldsw + _i * 8192), 16, 0, 0); } while (0)
#define PG8_LDA(dst, b, h) do { _Pragma("unroll") for (int m = 0; m < 4; ++m) _Pragma("unroll") for (int k = 0; k < 2; ++k) dst[m][k] = *(const PG8_LAS bf16x8*)(lds + PG8_SA(b, h) + aoff + m * 2048 + k * 1024); } while (0)
#define PG8_LDB(dst, b, h) do { _Pragma("unroll") for (int n = 0; n < 2; ++n) _Pragma("unroll") for (int k = 0; k < 2; ++k) dst[n][k] = *(const PG8_LAS bf16x8*)(lds + PG8_SB(b, h) + boff + n * 2048 + k * 1024); } while (0)
#define PG8_MMA(ai, bj, At, Bt) do { __builtin_amdgcn_s_setprio(1); _Pragma("unroll") for (int m = 0; m < 4; ++m) _Pragma("unroll") for (int n = 0; n < 2; ++n) _Pragma("unroll") for (int k = 0; k < 2; ++k) \
        acc[ai][bj][m][n] = __builtin_amdgcn_mfma_f32_16x16x32_bf16(Bt[n][k], At[m][k], acc[ai][bj][m][n], 0, 0, 0); __builtin_amdgcn_s_setprio(0); } while (0)
#define PG8_WAIT_V(n) asm volatile("s_waitcnt vmcnt(" #n ")" ::: "memory")
#define PG8_WAIT_L(n) asm volatile("s_waitcnt lgkmcnt(" #n ")" ::: "memory")
#define PG8_BAR __builtin_amdgcn_s_barrier()
#define PG8_SCHED __builtin_amdgcn_sched_barrier(0)
    Unit cur, nxt; int ui = 0;
    if (!S.next(0, cur)) return;
    f32x4 acc[2][2][4][2];
#pragma unroll
    for (int a = 0; a < 2; ++a)
#pragma unroll
        for (int b = 0; b < 2; ++b)
#pragma unroll
            for (int m = 0; m < 4; ++m)
#pragma unroll
                for (int n = 0; n < 2; ++n) acc[a][b][m][n] = (f32x4){0.f, 0.f, 0.f, 0.f};
    bf16x8 At[4][2], B0[2][2], B1[2][2];
    const char* cA = PG8_UA(cur); const char* cB = PG8_UB(cur);
    S.a_ready(cur);
    if constexpr (SP2) {
        PG8_STAGE(PG8_SB(0, 0), cB, voffB); PG8_STAGE(PG8_SB(0, 1), cB + hstepB, voffB); PG8_STAGE(PG8_SA(0, 0), cA, voffA); PG8_STAGE(PG8_SA(0, 1), cA + hstepA, voffA);
        if (wr == 1) PG8_BAR;
        PG8_WAIT_V(2); PG8_BAR;
        PG8_STAGE(PG8_SB(1, 0), cB + kstep, voffB); PG8_STAGE(PG8_SA(1, 0), cA + kstep, voffA); PG8_STAGE(PG8_SB(1, 1), cB + hstepB + kstep, voffB);
        PG8_WAIT_V(6); PG8_BAR;
    } else {
        PG8_STAGE(PG8_SB(0, 0), cB, voffB); PG8_STAGE(PG8_SA(0, 0), cA, voffA); PG8_STAGE(PG8_SB(0, 1), cB + hstepB, voffB); PG8_STAGE(PG8_SA(0, 1), cA + hstepA, voffA);
        if (wr == 1) PG8_BAR;
        PG8_WAIT_V(4); PG8_BAR;
        PG8_STAGE(PG8_SB(1, 0), cB + kstep, voffB); PG8_STAGE(PG8_SA(1, 0), cA + kstep, voffA); PG8_STAGE(PG8_SB(1, 1), cB + hstepB + kstep, voffB);
        PG8_WAIT_V(6); PG8_BAR;
    }
    for (;;) {
        const bool has_next = S.next(ui + 1, nxt);
        const char* nA = has_next ? PG8_UA(nxt) : cA; const char* nB = has_next ? PG8_UB(nxt) : cB;
        for (int t = 0; t < nt; t += 2) {
            const bool last = (t == nt - 2);
            const char* a1 = cA + (size_t)(t + 1) * kstep;
            const char* a2 = last ? nA : cA + (size_t)(t + 2) * kstep; const char* b2 = last ? nB : cB + (size_t)(t + 2) * kstep;
            const char* a3 = a2 + kstep; const char* b3 = b2 + kstep;
            if (last && has_next) S.a_ready(nxt);
            if constexpr (SP2) {
            PG8_LDB(B0, 0, 0); PG8_LDB(B1, 0, 1); PG8_SCHED; PG8_LDA(At, 0, 0); PG8_STAGE(PG8_SA(1, 1), a1 + hstepA, voffA);
            PG8_WAIT_V(8); PG8_WAIT_L(0); PG8_BAR; PG8_MMA(0, 0, At, B0); PG8_MMA(0, 1, At, B1); PG8_BAR; PG8_SCHED;
            PG8_LDA(At, 0, 1); PG8_STAGE(PG8_SB(0, 0), b2, voffB); PG8_STAGE(PG8_SB(0, 1), b2 + hstepB, voffB); PG8_STAGE(PG8_SA(0, 0), a2, voffA);
            PG8_WAIT_V(8); PG8_WAIT_L(0); PG8_BAR; PG8_MMA(1, 0, At, B0); PG8_MMA(1, 1, At, B1); PG8_BAR; PG8_SCHED;
            PG8_LDB(B0, 1, 0); PG8_LDB(B1, 1, 1); PG8_SCHED; PG8_LDA(At, 1, 0); PG8_STAGE(PG8_SA(0, 1), a2 + hstepA, voffA);
            PG8_WAIT_V(8); PG8_WAIT_L(0); PG8_BAR; PG8_MMA(0, 0, At, B0); PG8_MMA(0, 1, At, B1); PG8_BAR; PG8_SCHED;
            PG8_LDA(At, 1, 1); PG8_STAGE(PG8_SB(1, 0), b3, voffB); PG8_STAGE(PG8_SB(1, 1), b3 + hstepB, voffB); PG8_STAGE(PG8_SA(1, 0), a3, voffA);
            PG8_WAIT_V(8); PG8_WAIT_L(0); PG8_BAR; PG8_MMA(1, 0, At, B0); PG8_MMA(1, 1, At, B1); PG8_BAR; PG8_SCHED;
            } else {
            PG8_LDB(B0, 0, 0); PG8_SCHED; PG8_LDA(At, 0, 0); PG8_STAGE(PG8_SA(1, 1), a1 + hstepA, voffA);
            PG8_WAIT_L(8); PG8_BAR; PG8_WAIT_L(0); PG8_MMA(0, 0, At, B0); PG8_BAR; PG8_SCHED;
            PG8_LDB(B1, 0, 1); PG8_STAGE(PG8_SB(0, 0), b2, voffB);
            PG8_BAR; PG8_WAIT_L(0); PG8_MMA(0, 1, At, B1); PG8_BAR;
            PG8_LDA(At, 0, 1); PG8_STAGE(PG8_SA(0, 0), a2, voffA);
            PG8_BAR; PG8_WAIT_L(0); PG8_MMA(1, 0, At, B0); PG8_BAR; PG8_SCHED;
            PG8_STAGE(PG8_SB(0, 1), b2 + hstepB, voffB);
            PG8_WAIT_V(6); PG8_BAR; PG8_MMA(1, 1, At, B1); PG8_BAR;
            PG8_LDB(B0, 1, 0); PG8_SCHED; PG8_LDA(At, 1, 0); PG8_STAGE(PG8_SA(0, 1), a2 + hstepA, voffA);
            PG8_WAIT_L(8); PG8_BAR; PG8_WAIT_L(0); PG8_MMA(0, 0, At, B0); PG8_BAR; PG8_SCHED;
            PG8_LDB(B1, 1, 1); PG8_STAGE(PG8_SB(1, 0), b3, voffB);
            PG8_BAR; PG8_WAIT_L(0); PG8_MMA(0, 1, At, B1); PG8_BAR;
            PG8_LDA(At, 1, 1); PG8_STAGE(PG8_SA(1, 0), a3, voffA);
            PG8_BAR; PG8_WAIT_L(0); PG8_MMA(1, 0, At, B0); PG8_BAR; PG8_SCHED;
            PG8_STAGE(PG8_SB(1, 1), b3 + hstepB, voffB);
            PG8_WAIT_V(6); PG8_BAR; PG8_MMA(1, 1, At, B1); PG8_BAR;
            }
        }
        if constexpr (ALIGN_EPI) { if (wr == 0) PG8_BAR; }
        if constexpr (!Epi::AFTER_DRAIN) { E(acc, cur, wr, wc, fr, fq); S.done(cur); }
        if (!has_next) break;
#pragma unroll
        for (int a = 0; a < 2; ++a)
#pragma unroll
            for (int b = 0; b < 2; ++b)
#pragma unroll
                for (int m = 0; m < 4; ++m)
#pragma unroll
                    for (int n = 0; n < 2; ++n) acc[a][b][m][n] = (f32x4){0.f, 0.f, 0.f, 0.f};
        cur = nxt; cA = nA; cB = nB; ++ui;
        if constexpr (ALIGN_EPI) { if (wr == 1) PG8_BAR; }
    }
    PG8_WAIT_V(0);
    if constexpr (!ALIGN_EPI) { if (wr == 0) PG8_BAR; }
    PG8_BAR;
    if constexpr (Epi::AFTER_DRAIN) { E.fused(acc, cur, wr, wc, fr, fq, lds, wid, lane); S.done(cur); }
#undef PG8_SA
#undef PG8_SB
#undef PG8_STAGE
#undef PG8_LDA
#undef PG8_LDB
#undef PG8_MMA
#undef PG8_WAIT_V
#undef PG8_WAIT_L
#undef PG8_BAR
#undef PG8_SCHED
}
}

constexpr int DM = 2048, NB = 4, SEQ = 4096, MTOK = NB * SEQ;
constexpr int WA = 4096, GA = 1024, NH = 16, QKN = 128, QKR = 64, QKH = 192, VH = 128, KVL = 512, QL_ = 512, WB = 2048;
constexpr float EPS = 1e-6f;

typedef unsigned short bf16_t;
typedef float f32x4 __attribute__((ext_vector_type(4)));
typedef unsigned u32x4 __attribute__((ext_vector_type(4)));
typedef unsigned u32x2 __attribute__((ext_vector_type(2)));
typedef short bf16x8 __attribute__((ext_vector_type(8)));
#define LAS __attribute__((address_space(3)))

constexpr size_t MiB = 1u << 20;
constexpr size_t WS_COS = 0, WS_SIN = 2 * MiB, WS_SSQC = 4 * MiB, WS_SSQQ0 = 4 * MiB + 65536, WS_SSQQ1 = 4 * MiB + 131072, WS_SSQX = 4 * MiB + 196608  , WS_SSQKR = 4 * MiB + 458752  , WS_KR = 5 * MiB;
constexpr size_t WS_BAR = 9 * MiB;
constexpr size_t WS_W = 10 * MiB;
constexpr size_t WS_AWIN = WS_W, WS_AWG = WS_W + 32 * MiB, WS_AWOUT = WS_W + 40 * MiB;
constexpr size_t WS_BWC0 = WS_W, WS_BWIN1 = WS_W + 13 * MiB, WS_BWKVB = WS_W + 23 * MiB, WS_BWQB0 = WS_W + 27 * MiB, WS_BWQB1 = WS_W + 30 * MiB, WS_BWO0 = WS_W + 33 * MiB, WS_BWO1 = WS_W + 41 * MiB;
constexpr size_t WS_ACT = 66 * MiB;
constexpr size_t WS_XN = WS_ACT, WS_R0 = WS_ACT, WS_R1 = WS_ACT + 128 * MiB, WS_G = WS_ACT + 256 * MiB;
constexpr size_t WS_AWGB = WS_G, WS_WINUB = WS_G + 16 * MiB;
constexpr size_t WS_GB = WS_ACT + 64 * MiB, WS_OG = WS_GB  , WS_CB = WS_ACT + 128 * MiB, WS_QL = WS_ACT + 144 * MiB, WS_K = WS_ACT + 160 * MiB, WS_V = WS_ACT + 256 * MiB, WS_Q = WS_ACT + 320 * MiB;
constexpr size_t WS_W2 = 450 * MiB, WS_A1WIN = WS_W2, WS_A1WG = WS_W2 + 32 * MiB, WS_A1WOUT = WS_W2 + 40 * MiB;
constexpr size_t WS_XB2 = WS_ACT;
constexpr size_t WS_END = 506 * MiB;
constexpr int LDS_BYTES = 131072 + 8192, XCH_OFF = 131072  , MISC_OFF = 131072 + 4096;

__device__ __forceinline__ unsigned f2bf(float f) { unsigned u = __builtin_bit_cast(unsigned, f); return (u + 0x7fffu + ((u >> 16) & 1u)) >> 16; }
__device__ __forceinline__ unsigned pk2(float lo, float hi) { unsigned r; asm volatile("v_cvt_pk_bf16_f32 %0, %1, %2" : "=v"(r) : "v"(lo), "v"(hi)); return r; }
__device__ __forceinline__ float bflo(unsigned w) { return __builtin_bit_cast(float, w << 16); }
__device__ __forceinline__ float bfhi(unsigned w) { return __builtin_bit_cast(float, w & 0xffff0000u); }
__device__ __forceinline__ float silu_f(float v) { return v * __builtin_amdgcn_rcpf(1.0f + __builtin_amdgcn_exp2f(-1.4426950408889634f * v)); }
__device__ __forceinline__ float sum_fq(float v) {
    { auto rr = __builtin_amdgcn_permlane16_swap(__float_as_uint(v), __float_as_uint(v), false, false); v = __uint_as_float(rr[0]) + __uint_as_float(rr[1]); }
    { auto rr = __builtin_amdgcn_permlane32_swap(__float_as_uint(v), __float_as_uint(v), false, false); v = __uint_as_float(rr[0]) + __uint_as_float(rr[1]); }
    return v;
}
__device__ __forceinline__ float wave_sum(float v) {
#pragma unroll
    for (int o = 1; o < 64; o <<= 1) v += __shfl_xor(v, o);
    return v;
}

typedef const f32x4 (&AccT)[2][2][4][2];
#define EPI_ROWS(...) _Pragma("unroll") for (int ai = 0; ai < 2; ++ai) _Pragma("unroll") for (int m = 0; m < 4; ++m) { const int row = u.pm * 256 + ai * 128 + wr * 64 + m * 16 + fr; __VA_ARGS__ }
__device__ __forceinline__ u32x4 pack8(f32x4 a, f32x4 b) { u32x4 w; w.x = pk2(a[0], a[1]); w.y = pk2(a[2], a[3]); w.z = pk2(b[0], b[1]); w.w = pk2(b[2], b[3]); return w; }
__device__ __forceinline__ f32x4 silu4(f32x4 v) { return (f32x4){silu_f(v[0]), silu_f(v[1]), silu_f(v[2]), silu_f(v[3])}; }

struct EpiA1 {
    static constexpr bool PERM = true, AFTER_DRAIN = false, ALIGN = true;
    bf16_t* U; bf16_t* G; const float* ssqx;
    __device__ __forceinline__ void operator()(AccT acc, const pg8::Unit& u, int wr, int wc, int fr, int fq) const {
        const bool isg = u.pn >= 16; bf16_t* base = isg ? G : U; const int col0 = (isg ? u.pn - 16 : u.pn) * 256 + wc * 32 + fq * 8;
        EPI_ROWS(
            const float rx = 1.0f / sqrtf(ssqx[row] * (1.0f / DM) + EPS);
            _Pragma("unroll") for (int bj = 0; bj < 2; ++bj) { f32x4 v0 = acc[ai][bj][m][0] * rx, v1 = acc[ai][bj][m][1] * rx;
                if (isg) { v0 = silu4(v0); v1 = silu4(v1); }
                *(u32x4*)(base + (size_t)row * WA + col0 + bj * 128) = pack8(v0, v1); }
        )
    }
};
struct EpiWp {
    static constexpr bool PERM = true, AFTER_DRAIN = false, ALIGN = true;
    bf16_t* o0; bf16_t* o1;
    __device__ __forceinline__ void operator()(AccT acc, const pg8::Unit& u, int wr, int wc, int fr, int fq) const {
        const int col0 = u.pn * 256 + wc * 32 + fq * 8;
        EPI_ROWS(
            bf16_t* base = (row < WA ? o0 : o1) + (size_t)(row & (WA - 1)) * DM + col0;
            _Pragma("unroll") for (int bj = 0; bj < 2; ++bj) *(u32x4*)(base + bj * 128) = pack8(acc[ai][bj][m][0], acc[ai][bj][m][1]);
        )
    }
};
struct EpiRes {
    static constexpr bool PERM = true, AFTER_DRAIN = false, ALIGN = true;
    const bf16_t* res; float* out; bf16_t* xb; float* ssq;
    __device__ __forceinline__ void operator()(AccT acc, const pg8::Unit& u, int wr, int wc, int fr, int fq) const {
        const int col0 = u.pn * 256 + wc * 32 + fq * 8;
        EPI_ROWS(
            float s = 0.f;
            _Pragma("unroll") for (int bj = 0; bj < 2; ++bj) { const size_t off = (size_t)row * DM + col0 + bj * 128;
                const u32x4 rb = *(const u32x4*)(res + off);
                const f32x4 r0 = (f32x4){bflo(rb.x), bfhi(rb.x), bflo(rb.y), bfhi(rb.y)} + acc[ai][bj][m][0], r1 = (f32x4){bflo(rb.z), bfhi(rb.z), bflo(rb.w), bfhi(rb.w)} + acc[ai][bj][m][1];
                if (out) { *(f32x4*)(out + off) = r0; *(f32x4*)(out + off + 4) = r1; }
                if (xb) { *(u32x4*)(xb + off) = pack8(r0, r1);
                    s += (r0[0] * r0[0] + r0[1] * r0[1]) + (r0[2] * r0[2] + r0[3] * r0[3]) + (r1[0] * r1[0] + r1[1] * r1[1]) + (r1[2] * r1[2] + r1[3] * r1[3]); } }
            if (xb) { s = sum_fq(s); if (fq == 0) atomicAdd(ssq + row, s); }
        )
    }
};
struct EpiBin {
    static constexpr bool PERM = true, AFTER_DRAIN = false, ALIGN = true;
    bf16_t* Cb; bf16_t* QL; bf16_t* Gb; float* KR; float* ssqc; float* ssqq; int toff; const float* ssqx; float* ssqkr;
    __device__ __forceinline__ void operator()(AccT acc, const pg8::Unit& u, int wr, int wc, int fr, int fq) const {
        const int t = u.pn + toff; const int cw = wc * 32 + fq * 8;
        if (t >= 5) {
            const int col0 = (t - 5) * 256 + cw;
            EPI_ROWS(
                const float rx = 1.0f / sqrtf(ssqx[row] * (1.0f / DM) + EPS);
                _Pragma("unroll") for (int bj = 0; bj < 2; ++bj)
                    *(u32x4*)(Gb + (size_t)row * WB + col0 + bj * 128) = pack8(silu4(acc[ai][bj][m][0] * rx), silu4(acc[ai][bj][m][1] * rx));
            )
        } else if (t == 2) {
            if (wc < 2) {
                EPI_ROWS(
                    const float rx = 1.0f / sqrtf(ssqx[row] * (1.0f / DM) + EPS);
                    const f32x4 v0 = acc[ai][0][m][0] * rx, v1 = acc[ai][0][m][1] * rx;
                    *(f32x4*)(KR + (size_t)row * 64 + cw) = v0; *(f32x4*)(KR + (size_t)row * 64 + cw + 4) = v1;
                    float s = (v0[0] * v0[0] + v0[1] * v0[1]) + (v0[2] * v0[2] + v0[3] * v0[3]) + (v1[0] * v1[0] + v1[1] * v1[1]) + (v1[2] * v1[2] + v1[3] * v1[3]);
                    s = sum_fq(s);
                    if (fq == 0) atomicAdd(ssqkr + row, s);
                )
            }
        } else {
            const bool isq = t >= 3; bf16_t* base = isq ? QL : Cb; float* ssq = isq ? ssqq : ssqc; const int col0 = (isq ? t - 3 : t) * 256 + cw;
            EPI_ROWS(
                float s = 0.f; const float rx = 1.0f / sqrtf(ssqx[row] * (1.0f / DM) + EPS);
                _Pragma("unroll") for (int bj = 0; bj < 2; ++bj) { const f32x4 v0 = acc[ai][bj][m][0] * rx, v1 = acc[ai][bj][m][1] * rx;
                    s += (v0[0] * v0[0] + v0[1] * v0[1]) + (v0[2] * v0[2] + v0[3] * v0[3]) + (v1[0] * v1[0] + v1[1] * v1[1]) + (v1[2] * v1[2] + v1[3] * v1[3]);
                    *(u32x4*)(base + (size_t)row * 512 + col0 + bj * 128) = pack8(v0, v1); }
                s = sum_fq(s);
                if (fq == 0) atomicAdd(ssq + row, s);
            )
        }
    }
};
struct EpiKVb {
    static constexpr bool PERM = true, AFTER_DRAIN = false, ALIGN = true;
    bf16_t* K; bf16_t* V; const float* ssqc; const float* ssqkr; const float* KR; const float* gk; const float* cs; const float* sn; LAS float* xch;
    __device__ __forceinline__ void operator()(AccT acc, const pg8::Unit& u, int wr, int wc, int fr, int fq) const {
        const int cw = wc * 32 + fq * 8;
        float rc[2][4];
#pragma unroll
        for (int ai = 0; ai < 2; ++ai)
#pragma unroll
            for (int m = 0; m < 4; ++m) { const int rt = ai * 128 + wr * 64 + m * 16 + fr, row = u.pm * 256 + rt;
                rc[ai][m] = 1.0f / sqrtf(ssqc[row] * (1.0f / KVL) + EPS);
                const f32x4 v0 = acc[ai][0][m][0], v1 = acc[ai][0][m][1];
                float s = (v0[0] * v0[0] + v0[1] * v0[1]) + (v0[2] * v0[2] + v0[3] * v0[3]) + (v1[0] * v1[0] + v1[1] * v1[1]) + (v1[2] * v1[2] + v1[3] * v1[3]);
                s = sum_fq(s);
                if (fq == 0) xch[rt * 4 + wc] = s * rc[ai][m] * rc[ai][m]; }
        asm volatile("s_waitcnt lgkmcnt(0)" ::: "memory"); __builtin_amdgcn_s_barrier(); asm volatile("" ::: "memory");
        const f32x4 g0 = *(const f32x4*)(gk + cw), g1 = *(const f32x4*)(gk + cw + 4);
        const int i0 = (wc * 4 + fq) * 2;
        const float ga0 = gk[128 + i0], ga1 = gk[129 + i0], gb0 = gk[160 + i0], gb1 = gk[161 + i0];
#pragma unroll
        for (int ai = 0; ai < 2; ++ai)
#pragma unroll
            for (int m = 0; m < 4; ++m) { const int rt = ai * 128 + wr * 64 + m * 16 + fr, row = u.pm * 256 + rt;
                const f32x4 pp = *(const LAS f32x4*)(xch + rt * 4);
                const float rk = 1.0f / sqrtf(((pp[0] + pp[1]) + (pp[2] + pp[3]) + ssqkr[row]) * (1.0f / QKH) + EPS), rcv = rc[ai][m], rn = rcv * rk;
                const size_t R = (size_t)((row >> 12) * NH + u.pn) * SEQ + (row & (SEQ - 1));
                *(u32x4*)(K + R * QKH + cw) = pack8(acc[ai][0][m][0] * rn * g0, acc[ai][0][m][1] * rn * g1);
                *(u32x4*)(V + R * VH + cw) = pack8(acc[ai][1][m][0] * rcv, acc[ai][1][m][1] * rcv);
                const float a0 = KR[(size_t)row * 64 + i0] * rk * ga0, a1 = KR[(size_t)row * 64 + i0 + 1] * rk * ga1, b0 = KR[(size_t)row * 64 + 32 + i0] * rk * gb0, b1 = KR[(size_t)row * 64 + 33 + i0] * rk * gb1;
                const float c0 = cs[(size_t)row * 32 + i0], c1 = cs[(size_t)row * 32 + i0 + 1], s0 = sn[(size_t)row * 32 + i0], s1 = sn[(size_t)row * 32 + i0 + 1];
                *(unsigned*)(K + R * QKH + 128 + i0) = pk2(a0 * c0 - b0 * s0, a1 * c1 - b1 * s1);
                *(unsigned*)(K + R * QKH + 160 + i0) = pk2(b0 * c0 + a0 * s0, b1 * c1 + a1 * s1); }
    }
};
struct EpiQb {
    static constexpr bool PERM = true, AFTER_DRAIN = false, ALIGN = true;
    bf16_t* Q; const float* ssqq;
    __device__ __forceinline__ void operator()(AccT acc, const pg8::Unit& u, int wr, int wc, int fr, int fq) const {
        const int col0 = u.pn * 256 + wc * 32 + fq * 8;
        EPI_ROWS(
            const float rinv = 1.0f / sqrtf(ssqq[row] * (1.0f / QL_) + EPS);
            _Pragma("unroll") for (int bj = 0; bj < 2; ++bj) { const int col = col0 + bj * 128, head = col / QKH, d = col - head * QKH;
                const size_t R = (size_t)((row >> 12) * NH + head) * SEQ + (row & (SEQ - 1));
                *(u32x4*)(Q + R * QKH + d) = pack8(acc[ai][bj][m][0] * rinv, acc[ai][bj][m][1] * rinv); }
        )
    }
};
#define RLX_AGENT __ATOMIC_RELAXED, __HIP_MEMORY_SCOPE_AGENT
#define XB_TMO      128
#define XB_XCNT(j)  (256  + 64 * (j))
#define XB_XSUB(j)  (1280 + 64 * (j))
#define XB_XGEN(j)  (2304 + 64 * (j))
#define XB_TOP      3328
#define XB_TOPGEN   3392
#define XCD_BAR_WORDS 3456
#define XB_SPIN_CAP (1u << 18)

__device__ __forceinline__ unsigned xb_ld(unsigned* p)              { return __hip_atomic_load(p, __ATOMIC_RELAXED, __HIP_MEMORY_SCOPE_AGENT); }
__device__ __forceinline__ unsigned xb_add(unsigned* p, unsigned v) { return __hip_atomic_fetch_add(p, v, __ATOMIC_RELAXED, __HIP_MEMORY_SCOPE_AGENT); }
__device__ __forceinline__ unsigned xb_xcc_id() { return (unsigned)__builtin_amdgcn_s_getreg((3 << 11) | 20) & 0xFu; }
#define XB_SPIN(cond, bar) do { unsigned _sp = 0; while (cond) { __builtin_amdgcn_s_sleep(1); \
    if ((++_sp & 255u) == 0u) { if (xb_ld(&(bar)[XB_TMO])) break; if (_sp > XB_SPIN_CAP) { atomicAdd(&(bar)[XB_TMO], 1u); break; } } } } while (0)

struct XcdBarrier {
    unsigned* bar; unsigned x;
    volatile LAS unsigned* st;
};

__device__ __forceinline__ XcdBarrier xcd_barrier_post(unsigned* bar, volatile LAS unsigned* st) {
    XcdBarrier b; b.bar = bar; b.x = xb_xcc_id(); b.st = st;
    if (threadIdx.x == 0) (void)xb_add(&bar[XB_XCNT(b.x)], 1u);
    return b;
}
__device__ __forceinline__ void xcd_barrier_complete(unsigned* bar, unsigned x, unsigned& nloc, unsigned& nx) {
    const unsigned G = gridDim.x * gridDim.y * gridDim.z;
    unsigned sum, cnt, mine, sp = 0u;
    for (;;) {
        sum = 0u; cnt = 0u; mine = 0u;
#pragma unroll
        for (unsigned j = 0; j < 16; ++j) { const unsigned c = xb_ld(&bar[XB_XCNT(j)]); sum += c; cnt += (c > 0u) ? 1u : 0u; mine = (j == x) ? c : mine; }
        if (sum == G) break;
        __builtin_amdgcn_s_sleep(1);
        if ((++sp & 255u) == 0u) { if (xb_ld(&bar[XB_TMO])) break; if (sp > XB_SPIN_CAP) { atomicAdd(&bar[XB_TMO], 1u); break; } }
    }
    nloc = mine > 0u ? mine : 1u; nx = cnt > 0u ? cnt : 1u;
}

__device__ __forceinline__ void xcd_barrier(const XcdBarrier& b) {
    asm volatile("s_waitcnt vmcnt(0)" ::: "memory");
    __syncthreads();
    if (threadIdx.x == 0) {
        unsigned* bar = b.bar;
        __builtin_amdgcn_s_waitcnt(0);
        unsigned nloc = b.st[0], nx = b.st[1];
        if (nloc == 0u) { xcd_barrier_complete(bar, b.x, nloc, nx); b.st[0] = nloc; b.st[1] = nx; }
        const unsigned old = xb_add(&bar[XB_XSUB(b.x)], 1u);
        const unsigned gen = old / nloc;
        if (old + 1u == (gen + 1u) * nloc) {
            __builtin_amdgcn_fence(__ATOMIC_RELEASE, "agent");
            asm volatile("s_waitcnt vmcnt(0)" ::: "memory");
            const unsigned og = xb_add(&bar[XB_TOP], 1u);
            const unsigned tg = og / nx;
            if (og + 1u == (tg + 1u) * nx) xb_add(&bar[XB_TOPGEN], 1u);
            else XB_SPIN(xb_ld(&bar[XB_TOPGEN]) == tg, bar);
            __builtin_amdgcn_fence(__ATOMIC_ACQUIRE, "agent");
            xb_add(&bar[XB_XGEN(b.x)], 1u);
            asm volatile("s_waitcnt vmcnt(0)" ::: "memory");
        } else {
            XB_SPIN(xb_ld(&bar[XB_XGEN(b.x)]) == gen, bar);
            __builtin_amdgcn_fence(__ATOMIC_ACQUIRE, "agent");
            asm volatile("s_waitcnt vmcnt(0)" ::: "memory");
        }
    }
    __syncthreads();
}
namespace att {
using f32x16 = __attribute__((ext_vector_type(16))) float;
using s16x4  = __attribute__((ext_vector_type(4))) short;
constexpr int NW = 8, QBLK = 32, KVBLK = 64;
constexpr float SCALE = 0.07216878364870322f;
constexpr float THR = 8.f;
constexpr int SHM_V = KVBLK * VH * 2, SHM_K = KVBLK * QKH * 2;
constexpr int NSLOT = 3;
constexpr int LDS_KR = 0, LDS_VR = NSLOT * SHM_K, LDS_WSF = LDS_VR + NSLOT * SHM_V, SHM_ATTN = LDS_WSF + NW * 64 * 4;
#define KSWZ(row, ch) ((row) * 384 + ((((ch) ^ (((row) >> 1) & 7))) << 4))
#define SBAR() __builtin_amdgcn_sched_barrier(0)
__device__ __forceinline__ int crow(int r, int hi) { return (r & 3) + 8 * (r >> 2) + 4 * hi; }
__device__ __forceinline__ unsigned cvtpk(float lo, float hi) { unsigned r; asm volatile("v_cvt_pk_bf16_f32 %0, %1, %2" : "=v"(r) : "v"(lo), "v"(hi)); return r; }

__device__ __forceinline__ void partialSM(f32x16& p0, f32x16& p1, float& m_reg, float& mn, float& alpha, bool visible) {
  constexpr float C = SCALE * 1.4426950408889634f;
  if (__builtin_expect(!visible, 0)) { for (int r = 0; r < 16; ++r) { p0[r] = -1e30f; p1[r] = -1e30f; } asm volatile("" : "+v"(p0), "+v"(p1)); }
  float pmax = p0[0]; for (int r = 1; r < 16; ++r) pmax = fmaxf(pmax, p0[r]); for (int r = 0; r < 16; ++r) pmax = fmaxf(pmax, p1[r]);
  { auto rr = __builtin_amdgcn_permlane32_swap(__float_as_uint(pmax), __float_as_uint(pmax), false, false);
    pmax = fmaxf(__uint_as_float(rr[0]), __uint_as_float(rr[1])); }
  if (__builtin_expect(__all(pmax - m_reg <= THR / SCALE), 1)) { mn = m_reg; alpha = 1.f; }
  else { mn = fmaxf(m_reg, pmax); alpha = __builtin_amdgcn_exp2f((m_reg - mn) * C); m_reg = mn; }
  float mnC = -mn * C;
  for (int r = 0; r < 16; ++r) p0[r] = fmaf(p0[r], C, mnC); for (int r = 0; r < 16; ++r) p1[r] = fmaf(p1[r], C, mnC);
  for (int r = 0; r < 16; ++r) p0[r] = __builtin_amdgcn_exp2f(p0[r]);
}
__device__ __forceinline__ void finishSM(f32x16& p0, f32x16& p1, float alpha, float& l_reg, bf16x8& pa0, bf16x8& pa1, bf16x8& pa2, bf16x8& pa3) {
  for (int r = 0; r < 16; ++r) p1[r] = __builtin_amdgcn_exp2f(p1[r]);
  float ps = 0; for (int r = 0; r < 16; ++r) ps += p0[r]; for (int r = 0; r < 16; ++r) ps += p1[r];
  { auto rr = __builtin_amdgcn_permlane32_swap(__float_as_uint(ps), __float_as_uint(ps), false, false);
    ps = __uint_as_float(rr[0]) + __uint_as_float(rr[1]); }
  l_reg = l_reg * alpha + ps;
#define PK4(P, BASE, OUT) do { unsigned a0 = cvtpk(P[BASE + 0], P[BASE + 1]), a1 = cvtpk(P[BASE + 2], P[BASE + 3]);   \
    unsigned b0 = cvtpk(P[BASE + 4], P[BASE + 5]), b1 = cvtpk(P[BASE + 6], P[BASE + 7]);                              \
    auto r0 = __builtin_amdgcn_permlane32_swap(a0, b0, false, false); auto r1 = __builtin_amdgcn_permlane32_swap(a1, b1, false, false); \
    u32x4 w = {r0[0], r1[0], r0[1], r1[1]}; OUT = *reinterpret_cast<bf16x8*>(&w); } while (0)
  PK4(p0, 0, pa0); PK4(p0, 8, pa1); PK4(p1, 0, pa2); PK4(p1, 8, pa3);
#undef PK4
}
__device__ __forceinline__ void qkt(f32x16& p0, f32x16& p1, const int (&ka)[4], int slot_off, const bf16x8* qr) {
  constexpr int PD = 2;
  bf16x8 kf0[12], kf1[12]; int kb[4];
#pragma unroll
  for (int jj = 0; jj < 4; ++jj) kb[jj] = ka[jj] + slot_off;
  p0 = f32x16{}; p1 = f32x16{};
#define QK_ISSUE(s) do { \
    asm volatile("ds_read_b128 %0, %1 offset:%c2" : "=v"(kf0[s]) : "v"(kb[(s) & 3]), "i"(((s) >> 2) * 128) : "memory"); \
    asm volatile("ds_read_b128 %0, %1 offset:%c2" : "=v"(kf1[s]) : "v"(kb[(s) & 3]), "i"(((s) >> 2) * 128 + 12288) : "memory"); } while (0)
#pragma unroll
  for (int s = 0; s < PD; ++s) QK_ISSUE(s);
#pragma unroll
  for (int d0 = 0; d0 < 12; ++d0) {
    if (d0 + PD < 12) QK_ISSUE(d0 + PD);
    const int later = 2 * ((d0 + PD < 12 ? d0 + PD : 11) - d0);
    asm volatile("s_waitcnt lgkmcnt(%c2)" : "+v"(kf0[d0]), "+v"(kf1[d0]) : "i"(later));
    p0 = __builtin_amdgcn_mfma_f32_32x32x16_bf16(kf0[d0], qr[d0], p0, 0, 0, 0);
    p1 = __builtin_amdgcn_mfma_f32_32x32x16_bf16(kf1[d0], qr[d0], p1, 0, 0, 0);
  }
#undef QK_ISSUE
}
__device__ __forceinline__ void glds16(const void* gsrc, unsigned lds_dst) { unsigned keep;
  asm volatile("s_mov_b32 %0, m0\n\ts_mov_b32 m0, %2\n\ts_nop 0\n\tglobal_load_lds_dwordx4 %1, off\n\ts_mov_b32 m0, %0" : "=&s"(keep) : "v"(gsrc), "s"(lds_dst) : "memory"); }
__device__ __forceinline__ int v_st(int k, int c) { const int kk = (k & ~0xC) | ((k & 4) << 1) | ((k & 8) >> 1); return ((kk >> 3) * 4 + (c >> 5)) * 512 + ((kk & 7) * 32 + (c & 31)) * 2; }
__device__ __forceinline__ int v_rd_base(int lane) { return ((lane & 3) << 3) | (((lane >> 2) & 3) << 6) | (((lane >> 4) & 1) << 5) | (((lane >> 5) & 1) << 8); }
constexpr int v_rd_off(int d0, int ks, int half) { return d0 * 512 + ks * 4096 + half * 2048; }
template <int OFF> __device__ __forceinline__ s16x4 tr_read(int vb) {
  s16x4 r; asm volatile("ds_read_b64_tr_b16 %0, %1 offset:%2" : "=&v"(r) : "v"(vb), "i"(OFF) : "memory"); return r;
}
template <int KS> __device__ __forceinline__ void pv_ks(f32x16* o, int vb, bf16x8 pa) {
  const s16x4 l0 = tr_read<v_rd_off(0, KS, 0)>(vb), h0 = tr_read<v_rd_off(0, KS, 1)>(vb), l1 = tr_read<v_rd_off(1, KS, 0)>(vb), h1 = tr_read<v_rd_off(1, KS, 1)>(vb);
  const s16x4 l2 = tr_read<v_rd_off(2, KS, 0)>(vb), h2 = tr_read<v_rd_off(2, KS, 1)>(vb), l3 = tr_read<v_rd_off(3, KS, 0)>(vb), h3 = tr_read<v_rd_off(3, KS, 1)>(vb);
  asm volatile("s_waitcnt lgkmcnt(0)" ::: "memory"); SBAR();
#define PK(L, H) (bf16x8){L[0], L[1], L[2], L[3], H[0], H[1], H[2], H[3]}
  o[0] = __builtin_amdgcn_mfma_f32_32x32x16_bf16(pa, PK(l0, h0), o[0], 0, 0, 0);
  o[1] = __builtin_amdgcn_mfma_f32_32x32x16_bf16(pa, PK(l1, h1), o[1], 0, 0, 0);
  o[2] = __builtin_amdgcn_mfma_f32_32x32x16_bf16(pa, PK(l2, h2), o[2], 0, 0, 0);
  o[3] = __builtin_amdgcn_mfma_f32_32x32x16_bf16(pa, PK(l3, h3), o[3], 0, 0, 0);
#undef PK
}
__device__ __forceinline__ void pv_d0(f32x16* o, int vb, bf16x8 pa0, bf16x8 pa1, bf16x8 pa2, bf16x8 pa3) {
  pv_ks<0>(o, vb, pa0); pv_ks<1>(o, vb, pa1); pv_ks<2>(o, vb, pa2); pv_ks<3>(o, vb, pa3);
}

__device__ __forceinline__ void attn_unit(const bf16_t* __restrict__ Qh, const bf16_t* __restrict__ Kh, const bf16_t* __restrict__ Vh,
                                          const bf16_t* Gt, bf16_t* Ot  , int qb, char* lds,
                                          const float* __restrict__ gq, const float* __restrict__ cs_b, const float* __restrict__ sn_b) {
  int tid_l = threadIdx.x; asm volatile("" : "+v"(tid_l));
  const int tid = tid_l, wid = __builtin_amdgcn_readfirstlane(tid >> 6), lane = tid & 63, r32 = lane & 31, hi = lane >> 5;
  const unsigned lds0 = (unsigned)(uintptr_t)lds;
  float* ws = (float*)(lds + LDS_WSF) + wid * 64; float* li_l = ws; float* al_l = ws + 32;
  float m_reg = -1e30f, l_reg = 0; f32x16 o[4] = {}; bf16x8 qr[12];
  const int q0 = qb * 256;
  const bf16_t* Qw = Qh + (size_t)(q0 + wid * QBLK + r32) * QKH + hi * 8;
  int gko[3], gvo[2];
#pragma unroll
  for (int i = 0; i < 3; ++i) { const int q = (i * 8 + wid) * 64 + lane, row = q / 24, chs = q - row * 24, ch = chs ^ ((row >> 1) & 7); gko[i] = row * QKH + ch * 8; }
#pragma unroll
  for (int i = 0; i < 2; ++i) { const int q = (i * 8 + wid) * 64 + lane, st = q >> 5, kk = (st >> 2) * 8 + ((q & 31) >> 2), cc = (st & 3) * 32 + (q & 3) * 8;
    const int k = (kk & ~0xC) | ((kk & 4) << 1) | ((kk & 8) >> 1); gvo[i] = k * VH + cc; }
#define DMA_K(t, slot) do { _Pragma("unroll") for (int i_ = 0; i_ < 3; ++i_) glds16(Kh + (size_t)(t) * (KVBLK * QKH) + gko[i_], (unsigned)__builtin_amdgcn_readfirstlane(lds0 + LDS_KR + (slot) * SHM_K + (i_ * 8 + wid) * 1024)); } while (0)
#define DMA_V(t, slot) do { _Pragma("unroll") for (int i_ = 0; i_ < 2; ++i_) glds16(Vh + (size_t)(t) * (KVBLK * VH) + gvo[i_], (unsigned)__builtin_amdgcn_readfirstlane(lds0 + LDS_VR + (slot) * SHM_V + (i_ * 8 + wid) * 1024)); } while (0)
#define WAITBAR(N) asm volatile("s_waitcnt vmcnt(" #N ") lgkmcnt(0)\n\ts_barrier" ::: "memory")
  DMA_K(0, 0); DMA_V(0, 0); DMA_K(1, 1);
  {
    float xq[12][8]; float ss = 0.f;
#pragma unroll
    for (int d0 = 0; d0 < 12; ++d0) { const u32x4 w = *reinterpret_cast<const u32x4*>(Qw + d0 * 16);
      xq[d0][0] = bflo(w.x); xq[d0][1] = bfhi(w.x); xq[d0][2] = bflo(w.y); xq[d0][3] = bfhi(w.y); xq[d0][4] = bflo(w.z); xq[d0][5] = bfhi(w.z); xq[d0][6] = bflo(w.w); xq[d0][7] = bfhi(w.w);
#pragma unroll
      for (int k = 0; k < 8; ++k) ss += xq[d0][k] * xq[d0][k]; }
    { auto rr = __builtin_amdgcn_permlane32_swap(__float_as_uint(ss), __float_as_uint(ss), false, false); ss = __uint_as_float(rr[0]) + __uint_as_float(rr[1]); }
    const float rinv = 1.0f / sqrtf(ss * (1.0f / QKH) + EPS);
#pragma unroll
    for (int d0 = 0; d0 < 12; ++d0) { const f32x4 g0 = *(const f32x4*)(gq + d0 * 16 + hi * 8), g1 = *(const f32x4*)(gq + d0 * 16 + hi * 8 + 4);
#pragma unroll
      for (int k = 0; k < 4; ++k) { xq[d0][k] *= rinv * g0[k]; xq[d0][4 + k] *= rinv * g1[k]; } }
    const size_t trow = (size_t)(q0 + wid * QBLK + r32) * 32 + hi * 8;
#pragma unroll
    for (int p = 0; p < 2; ++p) { const f32x4 c0 = *(const f32x4*)(cs_b + trow + p * 16), c1 = *(const f32x4*)(cs_b + trow + p * 16 + 4), s0 = *(const f32x4*)(sn_b + trow + p * 16), s1 = *(const f32x4*)(sn_b + trow + p * 16 + 4);
#pragma unroll
      for (int k = 0; k < 8; ++k) { const float cc = k < 4 ? c0[k & 3] : c1[k & 3], sv = k < 4 ? s0[k & 3] : s1[k & 3]; const float a = xq[8 + p][k], b = xq[10 + p][k];
        xq[8 + p][k] = a * cc - b * sv; xq[10 + p][k] = b * cc + a * sv; } }
#pragma unroll
    for (int d0 = 0; d0 < 12; ++d0) { u32x4 w; w.x = cvtpk(xq[d0][0], xq[d0][1]); w.y = cvtpk(xq[d0][2], xq[d0][3]); w.z = cvtpk(xq[d0][4], xq[d0][5]); w.w = cvtpk(xq[d0][6], xq[d0][7]);
      qr[d0] = __builtin_bit_cast(bf16x8, w); }
  }
  int ka[4];
#pragma unroll
  for (int jj = 0; jj < 4; ++jj) ka[jj] = (int)(lds0 + LDS_KR) + r32 * 384 + (((2 * jj + hi) ^ ((r32 >> 1) & 7)) << 4);
  const int jmax = (q0 + wid * QBLK) >> 6;
  const int vb0 = (int)(lds0 + LDS_VR) + v_rd_base(lane);
#define RESC(a) do { if (__any((a) < 1.f)) { if (hi == 0) al_l[r32] = (a); asm volatile("s_waitcnt lgkmcnt(0)" ::: "memory"); \
    for (int d = 0; d < 4; ++d) for (int r = 0; r < 16; ++r) o[d][r] *= al_l[crow(r, hi)]; } } while (0)
  f32x16 pA0, pA1, pB0, pB1; float mnA, mnB, alA, alB; bf16x8 pa0, pa1, pa2, pa3; const int NT = (q0 + 256) / KVBLK;
  int s0 = 0, s1 = 1, s2 = 2;
#define ROT() do { const int t_ = s0; s0 = s1; s1 = s2; s2 = t_; } while (0)
  WAITBAR(0);
  DMA_K(2, s2); DMA_V(1, s1);
  qkt(pA0, pA1, ka, s0 * SHM_K, qr); partialSM(pA0, pA1, m_reg, mnA, alA, true);
  WAITBAR(5); ROT();
  for (int j = 1; j + 1 < NT; j += 2) {
    DMA_K(j + 2, s2); DMA_V(j + 1, s1);
    if (j <= jmax) { SBAR(); qkt(pB0, pB1, ka, s0 * SHM_K, qr); }
    if (j - 1 <= jmax) { finishSM(pA0, pA1, alA, l_reg, pa0, pa1, pa2, pa3); SBAR();
      pv_d0(o, vb0 + s2 * SHM_V, pa0, pa1, pa2, pa3); }
    if (j <= jmax) { partialSM(pB0, pB1, m_reg, mnB, alB, true); RESC(alB); }
    WAITBAR(5); ROT();
    const bool more = j + 3 < NT;
    if (more) DMA_K(j + 3, s2);
    DMA_V(j + 2, s1);
    if (j + 1 <= jmax) { SBAR(); qkt(pA0, pA1, ka, s0 * SHM_K, qr); }
    if (j <= jmax) { finishSM(pB0, pB1, alB, l_reg, pa0, pa1, pa2, pa3); SBAR();
      pv_d0(o, vb0 + s2 * SHM_V, pa0, pa1, pa2, pa3); }
    if (j + 1 <= jmax) { partialSM(pA0, pA1, m_reg, mnA, alA, true); RESC(alA); }
    if (more) WAITBAR(5); else WAITBAR(2);
    ROT();
  }
  if (NT - 1 <= jmax) { SBAR(); qkt(pB0, pB1, ka, s0 * SHM_K, qr); }
  if (NT - 2 <= jmax) { finishSM(pA0, pA1, alA, l_reg, pa0, pa1, pa2, pa3); SBAR();
    pv_d0(o, vb0 + s2 * SHM_V, pa0, pa1, pa2, pa3); }
  if (NT - 1 <= jmax) { partialSM(pB0, pB1, m_reg, mnB, alB, true); RESC(alB); }
  WAITBAR(0);
  if (NT - 1 <= jmax) { finishSM(pB0, pB1, alB, l_reg, pa0, pa1, pa2, pa3); SBAR();
    pv_d0(o, vb0 + s0 * SHM_V, pa0, pa1, pa2, pa3); }
  if (hi == 0) li_l[r32] = l_reg; asm volatile("s_waitcnt lgkmcnt(0)" ::: "memory");
  float rli[16];
#pragma unroll
  for (int r = 0; r < 16; ++r) rli[r] = __builtin_amdgcn_rcpf(li_l[crow(r, hi)]);
  const size_t rowb = (size_t)(q0 + wid * QBLK);
#pragma unroll
  for (int r = 0; r < 16; ++r) { const size_t off = (rowb + crow(r, hi)) * WB + r32;
#pragma unroll
    for (int d0 = 0; d0 < 4; ++d0) { const float g = __builtin_bit_cast(float, (unsigned)Gt[off + d0 * 32] << 16);
      Ot[off + d0 * 32] = (bf16_t)f2bf(o[d0][r] * rli[r] * g); } }
  asm volatile("s_waitcnt lgkmcnt(0)\n\ts_barrier" ::: "memory");
#undef DMA_K
#undef DMA_V
#undef WAITBAR
#undef RESC
#undef ROT
}
#undef SBAR
}
struct Ctx { int tid, lane, wave, gw, ngw; LAS unsigned char* lds; };

__device__ __forceinline__ void transpose_item(const float* __restrict__ W, int K, int N, int ldw, bf16_t* __restrict__ WT, int row_off, const float* __restrict__ gain, LAS float* scr, int item, int lane) {
    const int nblk = N / 32, kb = item / nblk, nb = item % nblk, k0 = 64 * kb, n0 = 32 * nb;
    float wv[32];
    const float* wp = W + (size_t)(k0 + (lane >> 5)) * ldw + n0 + (lane & 31);
#pragma unroll
    for (int i = 0; i < 32; ++i) wv[i] = __builtin_nontemporal_load(wp + (size_t)(2 * i) * ldw);
    if (gain) {
#pragma unroll
        for (int i = 0; i < 32; ++i) wv[i] *= gain[k0 + 2 * i + (lane >> 5)];
    }
#pragma unroll
    for (int i = 0; i < 32; ++i) scr[(2 * i + (lane >> 5)) * 33 + (lane & 31)] = wv[i];
    asm volatile("s_waitcnt lgkmcnt(0)" ::: "memory");
    const int c = lane & 7;
#pragma unroll
    for (int j = 0; j < 4; ++j) { const int n = (lane >> 3) + 8 * j; const LAS float* s = scr + (8 * c) * 33 + n;
        u32x4 o; o.x = pk2(s[0 * 33], s[1 * 33]); o.y = pk2(s[2 * 33], s[3 * 33]); o.z = pk2(s[4 * 33], s[5 * 33]); o.w = pk2(s[6 * 33], s[7 * 33]);
        *(u32x4*)(WT + (size_t)(row_off + n0 + n) * K + k0 + 8 * c) = o; }
    asm volatile("s_waitcnt lgkmcnt(0)" ::: "memory");
}
__device__ __forceinline__ void convert_weight(const Ctx& c, const float* W, int K, int N, bf16_t* WT, int row_off, const float* gain, int ldw = 0) {
    LAS float* scr = (LAS float*)(c.lds + c.wave * 16384);
    const int nitems = (K / 64) * (N / 32);
    for (int it = c.gw; it < nitems; it += c.ngw) transpose_item(W, K, N, ldw ? ldw : N, WT, row_off, gain, scr, it, c.lane);
}
__device__ __forceinline__ void convert_plain(const Ctx& c, const float* __restrict__ W, int K, int ncols, int ldw, bf16_t* __restrict__ out, int ldo, int coff, const float* __restrict__ gain) {
    const int per_row = ncols / 8, total = K * per_row, stride = c.ngw * 64;
    for (int i0 = c.gw * 64 + c.lane; i0 < total; i0 += 4 * stride) {
        f32x4 a[4], b[4]; int kk[4], cc[4];
#pragma unroll
        for (int u = 0; u < 4; ++u) { const int i = i0 + u * stride; const bool ok = i < total; const int ii = ok ? i : i0; kk[u] = ii / per_row; cc[u] = (ii - kk[u] * per_row) * 8;
            a[u] = __builtin_nontemporal_load((const f32x4*)(W + (size_t)kk[u] * ldw + cc[u])); b[u] = __builtin_nontemporal_load((const f32x4*)(W + (size_t)kk[u] * ldw + cc[u] + 4)); }
#pragma unroll
        for (int u = 0; u < 4; ++u) { if (i0 + u * stride < total) { const float g = gain[kk[u]]; *(u32x4*)(out + (size_t)kk[u] * ldo + coff + cc[u]) = pack8(a[u] * g, b[u] * g); } }
    }
}
__device__ __forceinline__ void xprep_rows(const Ctx& c, const float* __restrict__ x, bf16_t* __restrict__ xb, float* __restrict__ ssq) {
    for (int r = c.gw; r < MTOK; r += c.ngw) {
        const f32x4* xr = (const f32x4*)(x + (size_t)r * DM) + c.lane;
        f32x4 v[8]; float s = 0.f;
#pragma unroll
        for (int j = 0; j < 8; ++j) { v[j] = __builtin_nontemporal_load(xr + 64 * j); s += (v[j].x * v[j].x + v[j].y * v[j].y) + (v[j].z * v[j].z + v[j].w * v[j].w); }
        s = wave_sum(s);
        if (c.lane == 0) ssq[r] = s;
        u32x2* o = (u32x2*)(xb + (size_t)r * DM) + c.lane;
#pragma unroll
        for (int j = 0; j < 8; ++j) { u32x2 w; w.x = pk2(v[j].x, v[j].y); w.y = pk2(v[j].z, v[j].w); o[64 * j] = w; }
    }
}
__device__ __forceinline__ void rope_tables(const Ctx& c, const int* __restrict__ pos, float* __restrict__ cs, float* __restrict__ sn) {
    const int gt = c.gw * 64 + c.lane, ngt = c.ngw * 64;
    for (int i = gt; i < MTOK * 32; i += ngt) {
        const int t = i >> 5, f = i & 31;
        const float inv = exp2f(-(float)f * 0.41524101186092029f);
        const float ang = (float)pos[t] * inv;
        float sd, cd; sincosf(ang, &sd, &cd);
        cs[i] = cd; sn[i] = sd;
    }
}
__device__ __forceinline__ void load8(const bf16_t* p, float* f) { const u32x4 w = __builtin_nontemporal_load((const u32x4*)p); f[0] = bflo(w.x); f[1] = bfhi(w.x); f[2] = bflo(w.y); f[3] = bfhi(w.y); f[4] = bflo(w.z); f[5] = bfhi(w.z); f[6] = bflo(w.w); f[7] = bfhi(w.w); }
__device__ __forceinline__ void pool_phase(const Ctx& c, const bf16_t* __restrict__ U, bf16_t* __restrict__ P, const bf16_t* __restrict__ G, const float* __restrict__ scale) {
    constexpr int SEGL = 64, NSEG = MTOK / SEGL;
    for (int seg = blockIdx.x; seg < NSEG; seg += gridDim.x) {
        const int t0 = seg * SEGL, s0 = t0 & (SEQ - 1), col = c.tid * 8, w = 2 << (col >> 10);
        const bf16_t* Uc = U + col; bf16_t* Pc = P + col; const bf16_t* Gc = G + col;
        float sc[8];
#pragma unroll
        for (int k = 0; k < 8; ++k) sc[k] = scale[col + k];
        float sum[8];
#pragma unroll
        for (int k = 0; k < 8; ++k) sum[k] = 0.f;
        for (int i = 1; i <= w; ++i) { if (s0 - i >= 0) { float f[8]; load8(Uc + (size_t)(t0 - i) * WA, f);
#pragma unroll
            for (int k = 0; k < 8; ++k) sum[k] += f[k]; } }
        const float rw = 1.0f / (float)w;
#pragma unroll 4
        for (int i = 0; i < SEGL; ++i) {
            const int t = t0 + i, s = s0 + i; float f[8], old[8];
            load8(Uc + (size_t)t * WA, f);
            if (s >= w) load8(Uc + (size_t)(t - w) * WA, old); else {
#pragma unroll
                for (int k = 0; k < 8; ++k) old[k] = 0.f; }
            const float rc = (s + 1 < w) ? 1.0f / (float)(s + 1) : rw;
            float o[8], gt[8]; load8(Gc + (size_t)t * WA, gt);
#pragma unroll
            for (int k = 0; k < 8; ++k) { sum[k] += f[k] - old[k]; o[k] = (sum[k] * rc - f[k]) * sc[k] * gt[k]; }
            u32x4 pw; pw.x = pk2(o[0], o[1]); pw.y = pk2(o[2], o[3]); pw.z = pk2(o[4], o[5]); pw.w = pk2(o[6], o[7]);
            *(u32x4*)(Pc + (size_t)t * WA) = pw;
        }
    }
}
template <bool ISK>
__device__ __forceinline__ void qknorm_rope(const Ctx& c, bf16_t* __restrict__ T, const float* __restrict__ KR, const float* __restrict__ g, const float* __restrict__ cs, const float* __restrict__ sn) {
    const int l = c.lane & 7, sub = c.lane >> 3;
    float gn[16], g1[4], g2[4];
#pragma unroll
    for (int k = 0; k < 16; ++k) gn[k] = g[16 * l + k];
#pragma unroll
    for (int k = 0; k < 4; ++k) { g1[k] = g[128 + 4 * l + k]; g2[k] = g[160 + 4 * l + k]; }
    const int nvec = MTOK * NH;
    for (int v = c.gw * 8 + sub; v < nvec; v += c.ngw * 8) {
        const int s = v & (SEQ - 1), bh = v >> 12, tok = (bh >> 4) * SEQ + s;
        bf16_t* p = T + (size_t)v * QKH;
        float x[16], t1[4], t2[4];
        load8(p + 16 * l, x); load8(p + 16 * l + 8, x + 8);
        if (ISK) { const f32x4 a = *(const f32x4*)(KR + (size_t)tok * 64 + 4 * l), b = *(const f32x4*)(KR + (size_t)tok * 64 + 32 + 4 * l);
#pragma unroll
            for (int k = 0; k < 4; ++k) { t1[k] = a[k]; t2[k] = b[k]; } }
        else { const u32x2 a = *(const u32x2*)(p + 128 + 4 * l), b = *(const u32x2*)(p + 160 + 4 * l);
            t1[0] = bflo(a.x); t1[1] = bfhi(a.x); t1[2] = bflo(a.y); t1[3] = bfhi(a.y); t2[0] = bflo(b.x); t2[1] = bfhi(b.x); t2[2] = bflo(b.y); t2[3] = bfhi(b.y); }
        float ss = 0.f;
#pragma unroll
        for (int k = 0; k < 16; ++k) ss += x[k] * x[k];
#pragma unroll
        for (int k = 0; k < 4; ++k) ss += t1[k] * t1[k] + t2[k] * t2[k];
        ss += __shfl_xor(ss, 1); ss += __shfl_xor(ss, 2); ss += __shfl_xor(ss, 4);
        const float rinv = 1.0f / sqrtf(ss * (1.0f / QKH) + EPS);
        const f32x4 cc = *(const f32x4*)(cs + (size_t)tok * 32 + 4 * l), sv = *(const f32x4*)(sn + (size_t)tok * 32 + 4 * l);
        u32x4 w0, w1;
#pragma unroll
        for (int k = 0; k < 16; ++k) x[k] *= rinv * gn[k];
        w0.x = pk2(x[0], x[1]); w0.y = pk2(x[2], x[3]); w0.z = pk2(x[4], x[5]); w0.w = pk2(x[6], x[7]);
        w1.x = pk2(x[8], x[9]); w1.y = pk2(x[10], x[11]); w1.z = pk2(x[12], x[13]); w1.w = pk2(x[14], x[15]);
        float o1[4], o2[4];
#pragma unroll
        for (int k = 0; k < 4; ++k) { const float a = t1[k] * rinv * g1[k], b = t2[k] * rinv * g2[k]; o1[k] = a * cc[k] - b * sv[k]; o2[k] = b * cc[k] + a * sv[k]; }
        *(u32x4*)(p + 16 * l) = w0; *(u32x4*)(p + 16 * l + 8) = w1;
        u32x2 r1, r2; r1.x = pk2(o1[0], o1[1]); r1.y = pk2(o1[2], o1[3]); r2.x = pk2(o2[0], o2[1]); r2.y = pk2(o2[2], o2[3]);
        *(u32x2*)(p + 128 + 4 * l) = r1; *(u32x2*)(p + 160 + 4 * l) = r2;
    }
}
struct Args { const void* in[18]; float* out; unsigned char* ws; };
enum { I_X = 0, I_POS, I_ANG, I_AWIN, I_AWG, I_ASC, I_AWOUT, I_KVNG, I_KVWA, I_KVLG, I_KVWB, I_KNG, I_BNG, I_BWIN, I_BQLG, I_BWQB, I_BQNG, I_BWOUT };

#define GEMM_RUN_M(EPI, M_, gA, gB, N_, K_, LDA, LDB, AGD, AGS, BGD, BGS, ...) do { \
    pg8::Gemm g_{(const bf16_t*)(gA), (const bf16_t*)(gB), (M_), (N_), (K_), (LDA), (LDB), (AGD), (AGS), (BGD), (BGS)}; pg8::StaticOrder S_; S_.init((M_), (N_), (int)gridDim.x, (int)blockIdx.x); \
    EPI E_{__VA_ARGS__}; pg8::gemm_phase<EPI, pg8::StaticOrder, EPI::ALIGN, true>(c.lds, g_, S_, E_); } while (0)
#define GEMM_RUN(EPI, gA, gB, N_, K_, LDA, LDB, AGD, AGS, ...) GEMM_RUN_M(EPI, MTOK, gA, gB, N_, K_, LDA, LDB, AGD, AGS, NOGRP, 0, __VA_ARGS__)
constexpr int NOGRP = 1 << 30;

typedef const __attribute__((address_space(4))) Args* ArgsP;
__device__ __forceinline__ ArgsP get_args() { auto p = __builtin_amdgcn_kernarg_segment_ptr(); asm volatile("" : "+s"(p)); return (ArgsP)p; }
__device__ __forceinline__ Ctx make_ctx(unsigned char* lds_raw) {
    Ctx c; int tid = threadIdx.x; asm volatile("" : "+v"(tid)); c.tid = tid; c.lane = tid & 63; c.wave = __builtin_amdgcn_readfirstlane(tid >> 6); c.gw = blockIdx.x * 8 + c.wave; c.ngw = gridDim.x * 8; c.lds = (LAS unsigned char*)lds_raw; return c;
}
#define PHASE_BEGIN ArgsP ap = get_args(); unsigned char* ws = ap->ws; const Ctx c = make_ctx(lds_raw); (void)ws; (void)c;
#define INF(k) ((const float*)ap->in[k])
#define WSB(off) ((bf16_t*)(ws + (off)))
#define WSF(off) ((float*)(ws + (off)))

#define GRID_BAR() do { ArgsP ap_ = get_args(); XcdBarrier b_; b_.bar = (unsigned*)(ap_->ws + WS_BAR); b_.x = xb_xcc_id(); b_.st = (volatile LAS unsigned*)((LAS unsigned char*)lds_raw + MISC_OFF); xcd_barrier(b_); } while (0)

__global__ void __launch_bounds__(512, 2) yoco_fwd(Args a_unused) {
    extern __shared__ __attribute__((aligned(16))) unsigned char lds_raw[];
    cg::grid_group grid = cg::this_grid();
    if (threadIdx.x < 2) ((LAS unsigned*)((LAS unsigned char*)lds_raw + MISC_OFF))[threadIdx.x] = 0u;
    { ArgsP ap_ = get_args(); if (threadIdx.x == 0) (void)xb_add((unsigned*)(ap_->ws + WS_BAR) + XB_XCNT(xb_xcc_id()), 1u); }
    __syncthreads();

    {
        PHASE_BEGIN
        rope_tables(c, (const int*)ap->in[I_POS], WSF(WS_COS), WSF(WS_SIN));
        { float* z = WSF(WS_SSQC); for (int i = c.gw * 64 + c.lane; i < 3 * MTOK; i += c.ngw * 64) z[i] = 0.f; }
        { float* z = WSF(WS_SSQX) + MTOK; for (int i = c.gw * 64 + c.lane; i < 4 * MTOK; i += c.ngw * 64) z[i] = 0.f; }
        xprep_rows(c, INF(I_X), (bf16_t*)ap->out, WSF(WS_SSQX));
#pragma unroll 1
        for (int l = 0; l < 2; ++l) {
            const float* win = INF(I_AWIN) + (size_t)l * DM * 2 * WA; const float* gl = INF(I_ANG) + l * DM;
#pragma unroll 1
            for (int g = 0; g < 4; ++g) convert_weight(c, INF(I_AWG) + ((size_t)l * 4 + g) * GA * GA, GA, GA, WSB(WS_AWGB), l * WA + g * GA, nullptr);
            convert_plain(c, win, DM, WA, 2 * WA, WSB(WS_WINUB), 2 * WA, l * WA, gl);
            convert_weight(c, win + WA, DM, WA, WSB(l ? WS_A1WIN : WS_AWIN), WA, gl, 2 * WA);
            convert_weight(c, INF(I_AWOUT) + (size_t)l * WA * DM, WA, DM, WSB(l ? WS_A1WOUT : WS_AWOUT), 0, nullptr);
        }
    }
    if (gridDim.x == 0x7fffffffu) grid.sync();
    GRID_BAR();
    {
        PHASE_BEGIN
        GEMM_RUN_M(EpiWp, 2 * WA, WSB(WS_AWGB), WSB(WS_WINUB), DM, GA, GA, 2 * WA, NOGRP, 0, 4, GA, WSB(WS_AWIN), WSB(WS_A1WIN));
    }
    GRID_BAR();
#pragma unroll 1
    for (int l = 0; l < 2; ++l) {
        {
            PHASE_BEGIN
            GEMM_RUN(EpiA1, (bf16_t*)ap->out + (size_t)l * MTOK * DM, WSB(l ? WS_A1WIN : WS_AWIN), 2 * WA, DM, DM, DM, NOGRP, 0, WSB(l ? WS_R0 : WS_R1), WSB(WS_G), WSF(WS_SSQX) + l * MTOK);
        }
        GRID_BAR();
        {
            PHASE_BEGIN
            pool_phase(c, WSB(l ? WS_R0 : WS_R1), WSB(l ? WS_R1 : WS_R0), WSB(WS_G), INF(I_ASC) + l * WA);
            if (l == 1) {
                bf16_t* WC0 = WSB(WS_BWC0);
                convert_weight(c, INF(I_KVWA), DM, KVL + QKR, WC0, 0, INF(I_KVNG));
                { u32x4* z = (u32x4*)(WC0 + (size_t)(KVL + QKR) * DM); const int n16 = 192 * DM * 2 / 16; for (int i = c.gw * 64 + c.lane; i < n16; i += c.ngw * 64) z[i] = (u32x4){0u, 0u, 0u, 0u}; }
                convert_weight(c, INF(I_BWIN), DM, QL_ + WB, WC0, 768, INF(I_BNG));
            }
        }
        GRID_BAR();
        {
            PHASE_BEGIN
            GEMM_RUN(EpiRes, WSB(l ? WS_R1 : WS_R0), WSB(l ? WS_A1WOUT : WS_AWOUT), DM, WA, WA, WA, NOGRP, 0, (const bf16_t*)ap->out + (size_t)l * MTOK * DM, (float*)nullptr, (bf16_t*)ap->out + (size_t)(1 - l) * MTOK * DM, WSF(WS_SSQX) + (l + 1) * MTOK);
        }
        GRID_BAR();
    }
#pragma unroll 1
    for (int j = 0; j < 2; ++j) {
        {
            PHASE_BEGIN
            float* ssqq = WSF(j ? WS_SSQQ1 : WS_SSQQ0);
            GEMM_RUN(EpiBin, (j ? WSB(WS_XB2) : (bf16_t*)ap->out), WSB(j ? WS_BWIN1 : WS_BWC0), j ? 2560 : 3328, DM, DM, DM, NOGRP, 0, WSB(WS_CB), WSB(WS_QL), WSB(WS_GB), WSF(WS_KR), WSF(WS_SSQC), ssqq, j ? 3 : 0, WSF(WS_SSQX) + (2 + j) * MTOK, WSF(WS_SSQKR));
        }
        {
            PHASE_BEGIN
            if (j == 0) {
                const int G_ = gridDim.x, nfull = (G_ == 256) ? 64 : 0;
                if ((int)blockIdx.x >= nfull) {
                    Ctx c2 = c; c2.gw = ((int)blockIdx.x - nfull) * 8 + c.wave; c2.ngw = (G_ - nfull) * 8;
                    convert_weight(c2, INF(I_BWIN) + (size_t)DM * (QL_ + WB), DM, QL_ + WB, WSB(WS_BWIN1), 0, INF(I_BNG) + DM);
                    convert_weight(c2, INF(I_KVWB), KVL, NH * (QKN + VH), WSB(WS_BWKVB), 0, INF(I_KVLG));
#pragma unroll 1
                    for (int jj = 0; jj < 2; ++jj) {
                        convert_weight(c2, INF(I_BWQB) + (size_t)jj * QL_ * NH * QKH, QL_, NH * QKH, WSB(jj ? WS_BWQB1 : WS_BWQB0), 0, INF(I_BQLG) + jj * QL_);
                        convert_weight(c2, INF(I_BWOUT) + (size_t)jj * WB * DM, WB, DM, WSB(jj ? WS_BWO1 : WS_BWO0), 0, nullptr);
                    }
                }
            }
        }
        GRID_BAR();
        if (j == 0) {
            PHASE_BEGIN
            GEMM_RUN(EpiKVb, WSB(WS_CB), WSB(WS_BWKVB), NH * (QKN + VH), KVL, KVL, KVL, NOGRP, 0, WSB(WS_K), WSB(WS_V), WSF(WS_SSQC), WSF(WS_SSQKR), WSF(WS_KR), INF(I_KNG), WSF(WS_COS), WSF(WS_SIN), (LAS float*)(c.lds + XCH_OFF));
        }
        {
            PHASE_BEGIN
            GEMM_RUN(EpiQb, WSB(WS_QL), WSB(j ? WS_BWQB1 : WS_BWQB0), NH * QKH, QL_, QL_, QL_, NOGRP, 0, WSB(WS_Q), WSF(j ? WS_SSQQ1 : WS_SSQQ0));
        }
        GRID_BAR();
        {
            PHASE_BEGIN
            const int G_ = gridDim.x, bx = blockIdx.x; const int vcu = (G_ % 8 == 0) ? (bx % 8) * (G_ / 8) + bx / 8 : bx;
#pragma unroll 1
            for (int slot = vcu; slot < 256; slot += G_) {
                const int bh = slot >> 2, s = slot & 3, b = bh >> 4, h = bh & 15;
#pragma unroll 1
                for (int i = 0; i < 4; ++i) {
                    const int qb = (i == 0) ? 15 - s : (i == 1) ? 8 + s : (i == 2) ? 7 - s : s;
                    att::attn_unit(WSB(WS_Q) + (size_t)bh * SEQ * QKH, WSB(WS_K) + (size_t)bh * SEQ * QKH, WSB(WS_V) + (size_t)bh * SEQ * VH,
                                   WSB(WS_GB) + (size_t)b * SEQ * WB + h * VH, WSB(WS_OG) + (size_t)b * SEQ * WB + h * VH, qb, (char*)lds_raw,
                                   INF(I_BQNG) + j * QKH, WSF(WS_COS) + (size_t)b * SEQ * 32, WSF(WS_SIN) + (size_t)b * SEQ * 32);
                }
            }
        }
        GRID_BAR();
        {
            PHASE_BEGIN
            GEMM_RUN(EpiRes, WSB(WS_OG), WSB(j ? WS_BWO1 : WS_BWO0), DM, WB, WB, WB, NOGRP, 0, (j ? (const bf16_t*)WSB(WS_XB2) : (const bf16_t*)ap->out), (j ? ap->out : (float*)nullptr), (j == 0 ? WSB(WS_XB2) : (bf16_t*)nullptr), WSF(WS_SSQX) + 3 * MTOK);
        }
        if (j == 0) GRID_BAR();
    }
}

extern "C" void kernel_launch(void* const* d_in, const int* in_sizes, int n_in, void* d_out, int out_size, void* d_ws, size_t ws_size, hipStream_t stream) {
    static int grid_blocks = 0;
    if (grid_blocks == 0) {
        if (n_in != 18 || out_size != MTOK * DM || ws_size < WS_END) { fprintf(stderr, "kernel_launch: unexpected shapes n_in %d out %d ws %zu (need %zu)\n", n_in, out_size, ws_size, (size_t)WS_END); grid_blocks = -1; return; }
        int dev = 0, cus = 0, per_cu = 0;
        (void)hipGetDevice(&dev); (void)hipDeviceGetAttribute(&cus, hipDeviceAttributeMultiprocessorCount, dev);
        if (hipFuncSetAttribute((const void*)yoco_fwd, hipFuncAttributeMaxDynamicSharedMemorySize, LDS_BYTES) != hipSuccess) { fprintf(stderr, "kernel_launch: hipFuncSetAttribute failed\n"); grid_blocks = -1; return; }
        if (hipOccupancyMaxActiveBlocksPerMultiprocessor(&per_cu, (const void*)yoco_fwd, 512, LDS_BYTES) != hipSuccess || per_cu < 1) { fprintf(stderr, "kernel_launch: occupancy query gave %d\n", per_cu); per_cu = 1; }
        (void)hipGetLastError();
        grid_blocks = cus * 1;
        fprintf(stderr, "kernel_launch: cus %d per_cu %d grid %d ws %zu\n", cus, per_cu, grid_blocks, ws_size);
    }
    if (grid_blocks < 0) return;
    if (hipMemsetAsync((char*)d_ws + WS_BAR, 0, XCD_BAR_WORDS * 4, stream) != hipSuccess) { fprintf(stderr, "kernel_launch: hipMemsetAsync failed\n"); return; }
    Args a{};
    for (int i = 0; i < 18; ++i) a.in[i] = d_in[i];
    a.out = (float*)d_out; a.ws = (unsigned char*)d_ws;
    void* args[] = {&a};
    hipError_t e = hipLaunchCooperativeKernel((const void*)yoco_fwd, dim3(grid_blocks), dim3(512), args, LDS_BYTES, stream);
    if (e != hipSuccess) fprintf(stderr, "cooperative launch failed: %s (grid %d)\n", hipGetErrorString(e), grid_blocks);
}
```

```cpp
#include <hip/hip_runtime.h>
#include <hip/hip_cooperative_groups.h>
#include <hip/hip_bf16.h>
#include <cstdio>
#include <cstdint>
namespace cg = cooperative_groups;

namespace pg8 {
#define PG8_LAS __attribute__((address_space(3)))
typedef unsigned short bf16_t;
typedef short bf16x8 __attribute__((ext_vector_type(8)));
typedef float f32x4 __attribute__((ext_vector_type(4)));
typedef unsigned u32x4 __attribute__((ext_vector_type(4)));
constexpr int BM = 256, BK = 64, HALF = 128, HTB = HALF * BK * 2  , STAGE_BYTES = 8 * HTB, NXCD = 8, WGM = 8;

__host__ __device__ __forceinline__ int lds_byte(int r, int c) { const int st = (r >> 4) * 2 + (c >> 5), rr = r & 15, cc = c & 31, ob = rr * 64 + cc * 2; return st * 1024 + (ob ^ (((ob >> 9) & 1) << 5)); }
__host__ __device__ __forceinline__ void stage_rc(int b, int& R, int& C) { const int st = b / 1024, sb = b % 1024, swz = sb ^ (((sb >> 9) & 1) << 5); R = (st >> 1) * 16 + swz / 64; C = (st & 1) * 32 + (swz % 64) / 2; }
__host__ __device__ __forceinline__ int perm32(int rho) { const int n = rho >> 4, i = rho & 15; return 8 * (i >> 2) + 4 * n + (i & 3); }

struct Unit { int pm, pn; };
struct Gemm { const bf16_t* A; const bf16_t* Bt; int M, N, K, lda, ldb, agdiv, agstep, bgdiv, bgstep; };

struct StaticOrder {
    int nM, nN, nwg, G, c;
    __host__ __device__ void init(int M, int N, int G_, int c_) { nM = M / BM; nN = N / BM; nwg = nM * nN; G = G_; c = c_; }
    __host__ __device__ bool next(int i, Unit& u) const {
        const long L = (long)i * G + c; if (L >= nwg) return false;
        int wgid = (int)L; { const int q = nwg / NXCD, r = nwg % NXCD, xcd = wgid % NXCD, off = wgid / NXCD; wgid = (xcd < r ? xcd * (q + 1) : r * (q + 1) + (xcd - r) * q) + off; }
        const int nig = WGM * nN, gid = wgid / nig, fm = gid * WGM, gsz = (nM - fm) < WGM ? (nM - fm) : WGM;
        u.pm = fm + ((wgid % nig) % gsz); u.pn = (wgid % nig) / gsz; return true;
    }
    __device__ __forceinline__ void a_ready(const Unit&) const {}
    __device__ __forceinline__ void done(const Unit&) const {}
};

#define PG8_UA(u) ((const char*)g.A + (size_t)(u).pm * tstepA + (size_t)((u).pn / g.agdiv) * (size_t)g.agstep * 2)
#define PG8_UB(u) ((const char*)g.Bt + (size_t)(u).pn * tstepB + (size_t)((u).pm / g.bgdiv) * (size_t)g.bgstep * 2)
template <class Epi, class Sched, bool ALIGN_EPI = false, bool SP2 = false>
__device__ __forceinline__ void gemm_phase(PG8_LAS unsigned char* lds, const Gemm g, const Sched& S, const Epi& E) {
    int tid_l = threadIdx.x; asm volatile("" : "+v"(tid_l));
    const int tid = tid_l, wid = __builtin_amdgcn_readfirstlane(tid >> 6), lane = tid & 63, wr = wid >> 2, wc = wid & 3, fr = lane & 15, fq = lane >> 4;
    const int K = g.K, nt = K / BK;
    unsigned voffA[2], voffB[2];
#pragma unroll
    for (int i = 0; i < 2; ++i) { int R, C; stage_rc(tid * 16 + i * 8192, R, C); const int Rb = Epi::PERM ? ((R & ~31) + perm32(R & 31)) : R;
        voffA[i] = (unsigned)(R * g.lda + C) * 2u; voffB[i] = (unsigned)(Rb * g.ldb + C) * 2u; }
    const size_t kstep = (size_t)(BK * 2);
    const size_t hstepA = (size_t)HALF * g.lda * 2, hstepB = (size_t)HALF * g.ldb * 2;
    const size_t tstepA = 2 * hstepA, tstepB = 2 * hstepB;
    const unsigned ldsw = (unsigned)wid * 1024u;
    const int aoff = lds_byte(wr * 64 + fr, fq * 8), boff = lds_byte(wc * 32 + fr, fq * 8);
#define PG8_SA(b, h) (((b) * 2 + (h)) * HTB)
#define PG8_SB(b, h) ((4 + (b) * 2 + (h)) * HTB)
#define PG8_STAGE(bufoff, gbase, voff) do { _Pragma("unroll") for (int _i = 0; _i < 2; ++_i) \
        __builtin_amdgcn_global_load_lds((const unsigned*)((const char*)(gbase) + (voff)[_i]), (PG8_LAS unsigned*)(lds + (bufoff) + ldsw + _i * 8192), 16, 0, 0); } while (0)
#define PG8_LDA(dst, b, h) do { _Pragma("unroll") for (int m = 0; m < 4; ++m) _Pragma("unroll") for (int k = 0; k < 2; ++k) dst[m][k] = *(const PG8_LAS bf16x8*)(lds + PG8_SA(b, h) + aoff + m * 2048 + k * 1024); } while (0)
#define PG8_LDB(dst, b, h) do { _Pragma("unroll") for (int n = 0; n < 2; ++n) _Pragma("unroll") for (int k = 0; k < 2; ++k) dst[n][k] = *(const PG8_LAS bf16x8*)(lds + PG8_SB(b, h) + boff + n * 2048 + k * 1024); } while (0)
#define PG8_MMA(ai, bj, At, Bt) do { __builtin_amdgcn_s_setprio(1); _Pragma("unroll") for (int m = 0; m < 4; ++m) _Pragma("unroll") for (int n = 0; n < 2; ++n) _Pragma("unroll") for (int k = 0; k < 2; ++k) \
        acc[ai][bj][m][n] = __builtin_amdgcn_mfma_f32_16x16x32_bf16(Bt[n][k], At[m][k], acc[ai][bj][m][n], 0, 0, 0); __builtin_amdgcn_s_setprio(0); } while (0)
#define PG8_WAIT_V(n) asm volatile("s_waitcnt vmcnt(" #n ")" ::: "memory")
#define PG8_WAIT_L(n) asm volatile("s_waitcnt lgkmcnt(" #n ")" ::: "memory")
#define PG8_BAR __builtin_amdgcn_s_barrier()
#define PG8_SCHED __builtin_amdgcn_sched_barrier(0)
    Unit cur, nxt; int ui = 0;
    if (!S.next(0, cur)) return;
    f32x4 acc[2][2][4][2];
#pragma unroll
    for (int a = 0; a < 2; ++a)
#pragma unroll
        for (int b = 0; b < 2; ++b)
#pragma unroll
            for (int m = 0; m < 4; ++m)
#pragma unroll
                for (int n = 0; n < 2; ++n) acc[a][b][m][n] = (f32x4){0.f, 0.f, 0.f, 0.f};
    bf16x8 At[4][2], B0[2][2], B1[2][2];
    const char* cA = PG8_UA(cur); const char* cB = PG8_UB(cur);
    S.a_ready(cur);
    if constexpr (SP2) {
        PG8_STAGE(PG8_SB(0, 0), cB, voffB); PG8_STAGE(PG8_SB(0, 1), cB + hstepB, voffB); PG8_STAGE(PG8_SA(0, 0), cA, voffA); PG8_STAGE(PG8_SA(0, 1), cA + hstepA, voffA);
        if (wr == 1) PG8_BAR;
        PG8_WAIT_V(2); PG8_BAR;
        PG8_STAGE(PG8_SB(1, 0), cB + kstep, voffB); PG8_STAGE(PG8_SA(1, 0), cA + kstep, voffA); PG8_STAGE(PG8_SB(1, 1), cB + hstepB + kstep, voffB);
        PG8_WAIT_V(6); PG8_BAR;
    } else {
        PG8_STAGE(PG8_SB(0, 0), cB, voffB); PG8_STAGE(PG8_SA(0, 0), cA, voffA); PG8_STAGE(PG8_SB(0, 1), cB + hstepB, voffB); PG8_STAGE(PG8_SA(0, 1), cA + hstepA, voffA);
        if (wr == 1) PG8_BAR;
        PG8_WAIT_V(4); PG8_BAR;
        PG8_STAGE(PG8_SB(1, 0), cB + kstep, voffB); PG8_STAGE(PG8_SA(1, 0), cA + kstep, voffA); PG8_STAGE(PG8_SB(1, 1), cB + hstepB + kstep, voffB);
        PG8_WAIT_V(6); PG8_BAR;
    }
    for (;;) {
        const bool has_next = S.next(ui + 1, nxt);
        const char* nA = has_next ? PG8_UA(nxt) : cA; const char* nB = has_next ? PG8_UB(nxt) : cB;
        for (int t = 0; t < nt; t += 2) {
            const bool last = (t == nt - 2);
            const char* a1 = cA + (size_t)(t + 1) * kstep;
            const char* a2 = last ? nA : cA + (size_t)(t + 2) * kstep; const char* b2 = last ? nB : cB + (size_t)(t + 2) * kstep;
            const char* a3 = a2 + kstep; const char* b3 = b2 + kstep;
            if (last && has_next) S.a_ready(nxt);
            if constexpr (SP2) {
            PG8_LDB(B0, 0, 0); PG8_LDB(B1, 0, 1); PG8_SCHED; PG8_LDA(At, 0, 0); PG8_STAGE(PG8_SA(1, 1), a1 + hstepA, voffA);
            PG8_WAIT_V(8); PG8_WAIT_L(0); PG8_BAR; PG8_MMA(0, 0, At, B0); PG8_MMA(0, 1, At, B1); PG8_BAR; PG8_SCHED;
            PG8_LDA(At, 0, 1); PG8_STAGE(PG8_SB(0, 0), b2, voffB); PG8_STAGE(PG8_SB(0, 1), b2 + hstepB, voffB); PG8_STAGE(PG8_SA(0, 0), a2, voffA);
            PG8_WAIT_V(8); PG8_WAIT_L(0); PG8_BAR; PG8_MMA(1, 0, At, B0); PG8_MMA(1, 1, At, B1); PG8_BAR; PG8_SCHED;
            PG8_LDB(B0, 1, 0); PG8_LDB(B1, 1, 1); PG8_SCHED; PG8_LDA(At, 1, 0); PG8_STAGE(PG8_SA(0, 1), a2 + hstepA, voffA);
            PG8_WAIT_V(8); PG8_WAIT_L(0); PG8_BAR; PG8_MMA(0, 0, At, B0); PG8_MMA(0, 1, At, B1); PG8_BAR; PG8_SCHED;
            PG8_LDA(At, 1, 1); PG8_STAGE(PG8_SB(1, 0), b3, voffB); PG8_STAGE(PG8_SB(1, 1), b3 + hstepB, voffB); PG8_STAGE(PG8_SA(1, 0), a3, voffA);
            PG8_WAIT_V(8); PG8_WAIT_L(0); PG8_BAR; PG8_MMA(1, 0, At, B0); PG8_MMA(1, 1, At, B1); PG8_BAR; PG8_SCHED;
            } else {
            PG8_LDB(B0, 0, 0); PG8_SCHED; PG8_LDA(At, 0, 0); PG8_STAGE(PG8_SA(1, 1), a1 + hstepA, voffA);
            PG8_WAIT_L(8); PG8_BAR; PG8_WAIT_L(0); PG8_MMA(0, 0, At, B0); PG8_BAR; PG8_SCHED;
            PG8_LDB(B1, 0, 1); PG8_STAGE(PG8_SB(0, 0), b2, voffB);
            PG8_BAR; PG8_WAIT_L(0); PG8_MMA(0, 1, At, B1); PG8_BAR;
            PG8_LDA(At, 0, 1); PG8_STAGE(PG8_SA(0, 0), a2, voffA);
            PG8_BAR; PG8_WAIT_L(0); PG8_MMA(1, 0, At, B0); PG8_BAR; PG8_SCHED;
            PG8_STAGE(PG8_SB(0, 1), b2 + hstepB, voffB);
            PG8_WAIT_V(6); PG8_BAR; PG8_MMA(1, 1, At, B1); PG8_BAR;
            PG8_LDB(B0, 1, 0); PG8_SCHED; PG8_LDA(At, 1, 0); PG8_STAGE(PG8_SA(0, 1), a2 + hstepA, voffA);
            PG8_WAIT_L(8); PG8_BAR; PG8_WAIT_L(0); PG8_MMA(0, 0, At, B0); PG8_BAR; PG8_SCHED;
            PG8_LDB(B1, 1, 1); PG8_STAGE(PG8_SB(1, 0), b3, voffB);
            PG8_BAR; PG8_WAIT_L(0); PG8_MMA(0, 1, At, B1); PG8_BAR;
            PG8_LDA(At, 1, 1); PG8_STAGE(PG8_SA(1, 0), a3, voffA);
            PG8_BAR; PG8_WAIT_L(0); PG8_MMA(1, 0, At, B0); PG8_BAR; PG8_SCHED;
            PG8_STAGE(PG8_SB(1, 1), b3 + hstepB, voffB);
            PG8_WAIT_V(6); PG8_BAR; PG8_MMA(1, 1, At, B1); PG8_BAR;
            }
        }
        if constexpr (ALIGN_EPI) { if (wr == 0) PG8_BAR; }
        if constexpr (!Epi::AFTER_DRAIN) { E(acc, cur, wr, wc, fr, fq); S.done(cur); }
        if (!has_next) break;
#pragma unroll
        for (int a = 0; a < 2; ++a)
#pragma unroll
            for (int b = 0; b < 2; ++b)
#pragma unroll
                for (int m = 0; m < 4; ++m)
#pragma unroll
                    for (int n = 0; n < 2; ++n) acc[a][b][m][n] = (f32x4){0.f, 0.f, 0.f, 0.f};
        cur = nxt; cA = nA; cB = nB; ++ui;
        if constexpr (ALIGN_EPI) { if (wr == 1) PG8_BAR; }
    }
    PG8_WAIT_V(0);
    if constexpr (!ALIGN_EPI) { if (wr == 0) PG8_BAR; }
    PG8_BAR;
    if constexpr (Epi::AFTER_DRAIN) { E.fused(acc, cur, wr, wc, fr, fq, lds, wid, lane); S.done(cur); }
#undef PG8_SA
#undef PG8_SB
#undef PG8_STAGE
#undef PG8_LDA
#undef PG8_LDB
#undef PG8_MMA
#undef PG8_WAIT_V
#undef PG8_WAIT_L
#undef PG8_BAR
#undef PG8_SCHED
}
}

constexpr int DM = 2048, NB = 4, SEQ = 4096, MTOK = NB * SEQ;
constexpr int WA = 4096, GA = 1024, NH = 16, QKN = 128, QKR = 64, QKH = 192, VH = 128, KVL = 512, QL_ = 512, WB = 2048;
constexpr float EPS = 1e-6f;

typedef unsigned short bf16_t;
typedef float f32x4 __attribute__((ext_vector_type(4)));
typedef unsigned u32x4 __attribute__((ext_vector_type(4)));
typedef unsigned u32x2 __attribute__((ext_vector_type(2)));
typedef short bf16x8 __attribute__((ext_vector_type(8)));
#define LAS __attribute__((address_space(3)))

constexpr size_t MiB = 1u << 20;
constexpr size_t WS_COS = 0, WS_SIN = 2 * MiB, WS_SSQC = 4 * MiB, WS_SSQQ0 = 4 * MiB + 65536, WS_SSQQ1 = 4 * MiB + 131072, WS_SSQX = 4 * MiB + 196608  , WS_SSQKR = 4 * MiB + 458752  , WS_KR = 5 * MiB;
constexpr size_t WS_BAR = 9 * MiB;
constexpr size_t WS_W = 10 * MiB;
constexpr size_t WS_AWIN = WS_W, WS_AWG = WS_W + 32 * MiB, WS_AWOUT = WS_W + 40 * MiB;
constexpr size_t WS_BWC0 = WS_W, WS_BWIN1 = WS_W + 13 * MiB, WS_BWKVB = WS_W + 23 * MiB, WS_BWQB0 = WS_W + 27 * MiB, WS_BWQB1 = WS_W + 30 * MiB, WS_BWO0 = WS_W + 33 * MiB, WS_BWO1 = WS_W + 41 * MiB;
constexpr size_t WS_ACT = 66 * MiB;
constexpr size_t WS_XN = WS_ACT, WS_R0 = WS_ACT, WS_R1 = WS_ACT + 128 * MiB, WS_G = WS_ACT + 256 * MiB;
constexpr size_t WS_AWGB = WS_G, WS_WINUB = WS_G + 16 * MiB;
constexpr size_t WS_GB = WS_ACT + 64 * MiB, WS_OG = WS_GB  , WS_CB = WS_ACT + 128 * MiB, WS_QL = WS_ACT + 144 * MiB, WS_K = WS_ACT + 160 * MiB, WS_V = WS_ACT + 256 * MiB, WS_Q = WS_ACT + 320 * MiB;
constexpr size_t WS_W2 = 450 * MiB, WS_A1WIN = WS_W2, WS_A1WG = WS_W2 + 32 * MiB, WS_A1WOUT = WS_W2 + 40 * MiB;
constexpr size_t WS_XB2 = WS_ACT;
constexpr size_t WS_END = 506 * MiB;
constexpr int LDS_BYTES = 131072 + 8192, XCH_OFF = 131072  , MISC_OFF = 131072 + 4096;

__device__ __forceinline__ unsigned f2bf(float f) { unsigned u = __builtin_bit_cast(unsigned, f); return (u + 0x7fffu + ((u >> 16) & 1u)) >> 16; }
__device__ __forceinline__ unsigned pk2(float lo, float hi) { unsigned r; asm volatile("v_cvt_pk_bf16_f32 %0, %1, %2" : "=v"(r) : "v"(lo), "v"(hi)); return r; }
__device__ __forceinline__ float bflo(unsigned w) { return __builtin_bit_cast(float, w << 16); }
__device__ __forceinline__ float bfhi(unsigned w) { return __builtin_bit_cast(float, w & 0xffff0000u); }
__device__ __forceinline__ float silu_f(float v) { return v * __builtin_amdgcn_rcpf(1.0f + __builtin_amdgcn_exp2f(-1.4426950408889634f * v)); }
__device__ __forceinline__ float sum_fq(float v) {
    { auto rr = __builtin_amdgcn_permlane16_swap(__float_as_uint(v), __float_as_uint(v), false, false); v = __uint_as_float(rr[0]) + __uint_as_float(rr[1]); }
    { auto rr = __builtin_amdgcn_permlane32_swap(__float_as_uint(v), __float_as_uint(v), false, false); v = __uint_as_float(rr[0]) + __uint_as_float(rr[1]); }
    return v;
}
__device__ __forceinline__ float wave_sum(float v) {
#pragma unroll
    for (int o = 1; o < 64; o <<= 1) v += __shfl_xor(v, o);
    return v;
}

typedef const f32x4 (&AccT)[2][2][4][2];
#define EPI_ROWS(...) _Pragma("unroll") for (int ai = 0; ai < 2; ++ai) _Pragma("unroll") for (int m = 0; m < 4; ++m) { const int row = u.pm * 256 + ai * 128 + wr * 64 + m * 16 + fr; __VA_ARGS__ }
__device__ __forceinline__ u32x4 pack8(f32x4 a, f32x4 b) { u32x4 w; w.x = pk2(a[0], a[1]); w.y = pk2(a[2], a[3]); w.z = pk2(b[0], b[1]); w.w = pk2(b[2], b[3]); return w; }
__device__ __forceinline__ f32x4 silu4(f32x4 v) { return (f32x4){silu_f(v[0]), silu_f(v[1]), silu_f(v[2]), silu_f(v[3])}; }

struct EpiA1 {
    static constexpr bool PERM = true, AFTER_DRAIN = false, ALIGN = true;
    bf16_t* U; bf16_t* G; const float* ssqx;
    __device__ __forceinline__ void operator()(AccT acc, const pg8::Unit& u, int wr, int wc, int fr, int fq) const {
        const bool isg = u.pn >= 16; bf16_t* base = isg ? G : U; const int col0 = (isg ? u.pn - 16 : u.pn) * 256 + wc * 32 + fq * 8;
        EPI_ROWS(
            const float rx = 1.0f / sqrtf(ssqx[row] * (1.0f / DM) + EPS);
            _Pragma("unroll") for (int bj = 0; bj < 2; ++bj) { f32x4 v0 = acc[ai][bj][m][0] * rx, v1 = acc[ai][bj][m][1] * rx;
                if (isg) { v0 = silu4(v0); v1 = silu4(v1); }
                *(u32x4*)(base + (size_t)row * WA + col0 + bj * 128) = pack8(v0, v1); }
        )
    }
};
struct EpiWp {
    static constexpr bool PERM = true, AFTER_DRAIN = false, ALIGN = true;
    bf16_t* o0; bf16_t* o1;
    __device__ __forceinline__ void operator()(AccT acc, const pg8::Unit& u, int wr, int wc, int fr, int fq) const {
        const int col0 = u.pn * 256 + wc * 32 + fq * 8;
        EPI_ROWS(
            bf16_t* base = (row < WA ? o0 : o1) + (size_t)(row & (WA - 1)) * DM + col0;
            _Pragma("unroll") for (int bj = 0; bj < 2; ++bj) *(u32x4*)(base + bj * 128) = pack8(acc[ai][bj][m][0], acc[ai][bj][m][1]);
        )
    }
};
struct EpiRes {
    static constexpr bool PERM = true, AFTER_DRAIN = false, ALIGN = true;
    const bf16_t* res; float* out; bf16_t* xb; float* ssq;
    __device__ __forceinline__ void operator()(AccT acc, const pg8::Unit& u, int wr, int wc, int fr, int fq) const {
        const int col0 = u.pn * 256 + wc * 32 + fq * 8;
        EPI_ROWS(
            float s = 0.f;
            _Pragma("unroll") for (int bj = 0; bj < 2; ++bj) { const size_t off = (size_t)row * DM + col0 + bj * 128;
                const u32x4 rb = __builtin_nontemporal_load((const u32x4*)(res + off));
                const f32x4 r0 = (f32x4){bflo(rb.x), bfhi(rb.x), bflo(rb.y), bfhi(rb.y)} + acc[ai][bj][m][0], r1 = (f32x4){bflo(rb.z), bfhi(rb.z), bflo(rb.w), bfhi(rb.w)} + acc[ai][bj][m][1];
                if (out) { *(f32x4*)(out + off) = r0; *(f32x4*)(out + off + 4) = r1; }
                if (xb) { *(u32x4*)(xb + off) = pack8(r0, r1);
                    s += (r0[0] * r0[0] + r0[1] * r0[1]) + (r0[2] * r0[2] + r0[3] * r0[3]) + (r1[0] * r1[0] + r1[1] * r1[1]) + (r1[2] * r1[2] + r1[3] * r1[3]); } }
            if (xb) { s = sum_fq(s); if (fq == 0) atomicAdd(ssq + row, s); }
        )
    }
};
struct EpiBin {
    static constexpr bool PERM = true, AFTER_DRAIN = false, ALIGN = true;
    bf16_t* Cb; bf16_t* QL; bf16_t* Gb; float* KR; float* ssqc; float* ssqq; int toff; const float* ssqx; float* ssqkr;
    __device__ __forceinline__ void operator()(AccT acc, const pg8::Unit& u, int wr, int wc, int fr, int fq) const {
        const int t = u.pn + toff; const int cw = wc * 32 + fq * 8;
        if (t >= 5) {
            const int col0 = (t - 5) * 256 + cw;
            EPI_ROWS(
                const float rx = 1.0f / sqrtf(ssqx[row] * (1.0f / DM) + EPS);
                _Pragma("unroll") for (int bj = 0; bj < 2; ++bj)
                    *(u32x4*)(Gb + (size_t)row * WB + col0 + bj * 128) = pack8(silu4(acc[ai][bj][m][0] * rx), silu4(acc[ai][bj][m][1] * rx));
            )
        } else if (t == 2) {
            if (wc < 2) {
                EPI_ROWS(
                    const float rx = 1.0f / sqrtf(ssqx[row] * (1.0f / DM) + EPS);
                    const f32x4 v0 = acc[ai][0][m][0] * rx, v1 = acc[ai][0][m][1] * rx;
                    *(f32x4*)(KR + (size_t)row * 64 + cw) = v0; *(f32x4*)(KR + (size_t)row * 64 + cw + 4) = v1;
                    float s = (v0[0] * v0[0] + v0[1] * v0[1]) + (v0[2] * v0[2] + v0[3] * v0[3]) + (v1[0] * v1[0] + v1[1] * v1[1]) + (v1[2] * v1[2] + v1[3] * v1[3]);
                    s = sum_fq(s);
                    if (fq == 0) atomicAdd(ssqkr + row, s);
                )
            }
        } else {
            const bool isq = t >= 3; bf16_t* base = isq ? QL : Cb; float* ssq = isq ? ssqq : ssqc; const int col0 = (isq ? t - 3 : t) * 256 + cw;
            EPI_ROWS(
                float s = 0.f; const float rx = 1.0f / sqrtf(ssqx[row] * (1.0f / DM) + EPS);
                _Pragma("unroll") for (int bj = 0; bj < 2; ++bj) { const f32x4 v0 = acc[ai][bj][m][0] * rx, v1 = acc[ai][bj][m][1] * rx;
                    s += (v0[0] * v0[0] + v0[1] * v0[1]) + (v0[2] * v0[2] + v0[3] * v0[3]) + (v1[0] * v1[0] + v1[1] * v1[1]) + (v1[2] * v1[2] + v1[3] * v1[3]);
                    *(u32x4*)(base + (size_t)row * 512 + col0 + bj * 128) = pack8(v0, v1); }
                s = sum_fq(s);
                if (fq == 0) atomicAdd(ssq + row, s);
            )
        }
    }
};
struct EpiKVb {
    static constexpr bool PERM = true, AFTER_DRAIN = false, ALIGN = true;
    bf16_t* K; bf16_t* V; const float* ssqc; const float* ssqkr; const float* KR; const float* gk; const float* cs; const float* sn; LAS float* xch;
    __device__ __forceinline__ void operator()(AccT acc, const pg8::Unit& u, int wr, int wc, int fr, int fq) const {
        const int cw = wc * 32 + fq * 8;
        float rc[2][4];
#pragma unroll
        for (int ai = 0; ai < 2; ++ai)
#pragma unroll
            for (int m = 0; m < 4; ++m) { const int rt = ai * 128 + wr * 64 + m * 16 + fr, row = u.pm * 256 + rt;
                rc[ai][m] = 1.0f / sqrtf(ssqc[row] * (1.0f / KVL) + EPS);
                const f32x4 v0 = acc[ai][0][m][0], v1 = acc[ai][0][m][1];
                float s = (v0[0] * v0[0] + v0[1] * v0[1]) + (v0[2] * v0[2] + v0[3] * v0[3]) + (v1[0] * v1[0] + v1[1] * v1[1]) + (v1[2] * v1[2] + v1[3] * v1[3]);
                s = sum_fq(s);
                if (fq == 0) xch[rt * 4 + wc] = s * rc[ai][m] * rc[ai][m]; }
        asm volatile("s_waitcnt lgkmcnt(0)" ::: "memory"); __builtin_amdgcn_s_barrier(); asm volatile("" ::: "memory");
        const f32x4 g0 = *(const f32x4*)(gk + cw), g1 = *(const f32x4*)(gk + cw + 4);
        const int i0 = (wc * 4 + fq) * 2;
        const float ga0 = gk[128 + i0], ga1 = gk[129 + i0], gb0 = gk[160 + i0], gb1 = gk[161 + i0];
#pragma unroll
        for (int ai = 0; ai < 2; ++ai)
#pragma unroll
            for (int m = 0; m < 4; ++m) { const int rt = ai * 128 + wr * 64 + m * 16 + fr, row = u.pm * 256 + rt;
                const f32x4 pp = *(const LAS f32x4*)(xch + rt * 4);
                const float rk = 1.0f / sqrtf(((pp[0] + pp[1]) + (pp[2] + pp[3]) + ssqkr[row]) * (1.0f / QKH) + EPS), rcv = rc[ai][m], rn = rcv * rk;
                const size_t R = (size_t)((row >> 12) * NH + u.pn) * SEQ + (row & (SEQ - 1));
                *(u32x4*)(K + R * QKH + cw) = pack8(acc[ai][0][m][0] * rn * g0, acc[ai][0][m][1] * rn * g1);
                *(u32x4*)(V + R * VH + cw) = pack8(acc[ai][1][m][0] * rcv, acc[ai][1][m][1] * rcv);
                const float a0 = KR[(size_t)row * 64 + i0] * rk * ga0, a1 = KR[(size_t)row * 64 + i0 + 1] * rk * ga1, b0 = KR[(size_t)row * 64 + 32 + i0] * rk * gb0, b1 = KR[(size_t)row * 64 + 33 + i0] * rk * gb1;
                const float c0 = cs[(size_t)row * 32 + i0], c1 = cs[(size_t)row * 32 + i0 + 1], s0 = sn[(size_t)row * 32 + i0], s1 = sn[(size_t)row * 32 + i0 + 1];
                *(unsigned*)(K + R * QKH + 128 + i0) = pk2(a0 * c0 - b0 * s0, a1 * c1 - b1 * s1);
                *(unsigned*)(K + R * QKH + 160 + i0) = pk2(b0 * c0 + a0 * s0, b1 * c1 + a1 * s1); }
    }
};
struct EpiQb {
    static constexpr bool PERM = true, AFTER_DRAIN = false, ALIGN = true;
    bf16_t* Q; const float* ssqq;
    __device__ __forceinline__ void operator()(AccT acc, const pg8::Unit& u, int wr, int wc, int fr, int fq) const {
        const int col0 = u.pn * 256 + wc * 32 + fq * 8;
        EPI_ROWS(
            const float rinv = 1.0f / sqrtf(ssqq[row] * (1.0f / QL_) + EPS);
            _Pragma("unroll") for (int bj = 0; bj < 2; ++bj) { const int col = col0 + bj * 128, head = col / QKH, d = col - head * QKH;
                const size_t R = (size_t)((row >> 12) * NH + head) * SEQ + (row & (SEQ - 1));
                *(u32x4*)(Q + R * QKH + d) = pack8(acc[ai][bj][m][0] * rinv, acc[ai][bj][m][1] * rinv); }
        )
    }
};
#define RLX_AGENT __ATOMIC_RELAXED, __HIP_MEMORY_SCOPE_AGENT
#define XB_TMO      128
#define XB_XCNT(j)  (256  + 64 * (j))
#define XB_XSUB(j)  (1280 + 64 * (j))
#define XB_XGEN(j)  (2304 + 64 * (j))
#define XB_TOP      3328
#define XB_TOPGEN   3392
#define XCD_BAR_WORDS 3456
#define XB_SPIN_CAP (1u << 18)

__device__ __forceinline__ unsigned xb_ld(unsigned* p)              { return __hip_atomic_load(p, __ATOMIC_RELAXED, __HIP_MEMORY_SCOPE_AGENT); }
__device__ __forceinline__ unsigned xb_add(unsigned* p, unsigned v) { return __hip_atomic_fetch_add(p, v, __ATOMIC_RELAXED, __HIP_MEMORY_SCOPE_AGENT); }
__device__ __forceinline__ unsigned xb_xcc_id() { return (unsigned)__builtin_amdgcn_s_getreg((3 << 11) | 20) & 0xFu; }
#define XB_SPIN(cond, bar) do { unsigned _sp = 0; while (cond) { __builtin_amdgcn_s_sleep(1); \
    if ((++_sp & 255u) == 0u) { if (xb_ld(&(bar)[XB_TMO])) break; if (_sp > XB_SPIN_CAP) { atomicAdd(&(bar)[XB_TMO], 1u); break; } } } } while (0)

struct XcdBarrier {
    unsigned* bar; unsigned x;
    volatile LAS unsigned* st;
};

__device__ __forceinline__ XcdBarrier xcd_barrier_post(unsigned* bar, volatile LAS unsigned* st) {
    XcdBarrier b; b.bar = bar; b.x = xb_xcc_id(); b.st = st;
    if (threadIdx.x == 0) (void)xb_add(&bar[XB_XCNT(b.x)], 1u);
    return b;
}
__device__ __forceinline__ void xcd_barrier_complete(unsigned* bar, unsigned x, unsigned& nloc, unsigned& nx) {
    const unsigned G = gridDim.x * gridDim.y * gridDim.z;
    unsigned sum, cnt, mine, sp = 0u;
    for (;;) {
        sum = 0u; cnt = 0u; mine = 0u;
#pragma unroll
        for (unsigned j = 0; j < 16; ++j) { const unsigned c = xb_ld(&bar[XB_XCNT(j)]); sum += c; cnt += (c > 0u) ? 1u : 0u; mine = (j == x) ? c : mine; }
        if (sum == G) break;
        __builtin_amdgcn_s_sleep(1);
        if ((++sp & 255u) == 0u) { if (xb_ld(&bar[XB_TMO])) break; if (sp > XB_SPIN_CAP) { atomicAdd(&bar[XB_TMO], 1u); break; } }
    }
    nloc = mine > 0u ? mine : 1u; nx = cnt > 0u ? cnt : 1u;
}

__device__ __forceinline__ void xcd_barrier(const XcdBarrier& b) {
    asm volatile("s_waitcnt vmcnt(0)" ::: "memory");
    __syncthreads();
    if (threadIdx.x == 0) {
        unsigned* bar = b.bar;
        __builtin_amdgcn_s_waitcnt(0);
        unsigned nloc = b.st[0], nx = b.st[1];
        if (nloc == 0u) { xcd_barrier_complete(bar, b.x, nloc, nx); b.st[0] = nloc; b.st[1] = nx; }
        const unsigned old = xb_add(&bar[XB_XSUB(b.x)], 1u);
        const unsigned gen = old / nloc;
        if (old + 1u == (gen + 1u) * nloc) {
            __builtin_amdgcn_fence(__ATOMIC_RELEASE, "agent");
            asm volatile("s_waitcnt vmcnt(0)" ::: "memory");
            const unsigned og = xb_add(&bar[XB_TOP], 1u);
            const unsigned tg = og / nx;
            if (og + 1u == (tg + 1u) * nx) xb_add(&bar[XB_TOPGEN], 1u);
            else XB_SPIN(xb_ld(&bar[XB_TOPGEN]) == tg, bar);
            __builtin_amdgcn_fence(__ATOMIC_ACQUIRE, "agent");
            xb_add(&bar[XB_XGEN(b.x)], 1u);
            asm volatile("s_waitcnt vmcnt(0)" ::: "memory");
        } else {
            XB_SPIN(xb_ld(&bar[XB_XGEN(b.x)]) == gen, bar);
            __builtin_amdgcn_fence(__ATOMIC_ACQUIRE, "agent");
            asm volatile("s_waitcnt vmcnt(0)" ::: "memory");
        }
    }
    __syncthreads();
}
namespace att {
using f32x16 = __attribute__((ext_vector_type(16))) float;
using s16x4  = __attribute__((ext_vector_type(4))) short;
constexpr int NW = 8, QBLK = 32, KVBLK = 64;
constexpr float SCALE = 0.07216878364870322f;
constexpr float THR = 8.f;
constexpr int SHM_V = KVBLK * VH * 2, SHM_K = KVBLK * QKH * 2;
constexpr int NSLOT = 3;
constexpr int LDS_KR = 0, LDS_VR = NSLOT * SHM_K, LDS_WSF = LDS_VR + NSLOT * SHM_V, SHM_ATTN = LDS_WSF + NW * 64 * 4;
#define KSWZ(row, ch) ((row) * 384 + ((((ch) ^ (((row) >> 1) & 7))) << 4))
#define SBAR() __builtin_amdgcn_sched_barrier(0)
__device__ __forceinline__ int crow(int r, int hi) { return (r & 3) + 8 * (r >> 2) + 4 * hi; }
__device__ __forceinline__ unsigned cvtpk(float lo, float hi) { unsigned r; asm volatile("v_cvt_pk_bf16_f32 %0, %1, %2" : "=v"(r) : "v"(lo), "v"(hi)); return r; }

__device__ __forceinline__ void partialSM(f32x16& p0, f32x16& p1, float& m_reg, float& mn, float& alpha, bool visible) {
  constexpr float C = SCALE * 1.4426950408889634f;
  if (__builtin_expect(!visible, 0)) { for (int r = 0; r < 16; ++r) { p0[r] = -1e30f; p1[r] = -1e30f; } asm volatile("" : "+v"(p0), "+v"(p1)); }
  float pmax = p0[0]; for (int r = 1; r < 16; ++r) pmax = fmaxf(pmax, p0[r]); for (int r = 0; r < 16; ++r) pmax = fmaxf(pmax, p1[r]);
  { auto rr = __builtin_amdgcn_permlane32_swap(__float_as_uint(pmax), __float_as_uint(pmax), false, false);
    pmax = fmaxf(__uint_as_float(rr[0]), __uint_as_float(rr[1])); }
  if (__builtin_expect(__all(pmax - m_reg <= THR / SCALE), 1)) { mn = m_reg; alpha = 1.f; }
  else { mn = fmaxf(m_reg, pmax); alpha = __builtin_amdgcn_exp2f((m_reg - mn) * C); m_reg = mn; }
  float mnC = -mn * C;
  for (int r = 0; r < 16; ++r) p0[r] = fmaf(p0[r], C, mnC); for (int r = 0; r < 16; ++r) p1[r] = fmaf(p1[r], C, mnC);
  for (int r = 0; r < 16; ++r) p0[r] = __builtin_amdgcn_exp2f(p0[r]);
}
__device__ __forceinline__ void finishSM(f32x16& p0, f32x16& p1, float alpha, float& l_reg, bf16x8& pa0, bf16x8& pa1, bf16x8& pa2, bf16x8& pa3) {
  for (int r = 0; r < 16; ++r) p1[r] = __builtin_amdgcn_exp2f(p1[r]);
  float ps = 0; for (int r = 0; r < 16; ++r) ps += p0[r]; for (int r = 0; r < 16; ++r) ps += p1[r];
  { auto rr = __builtin_amdgcn_permlane32_swap(__float_as_uint(ps), __float_as_uint(ps), false, false);
    ps = __uint_as_float(rr[0]) + __uint_as_float(rr[1]); }
  l_reg = l_reg * alpha + ps;
#define PK4(P, BASE, OUT) do { unsigned a0 = cvtpk(P[BASE + 0], P[BASE + 1]), a1 = cvtpk(P[BASE + 2], P[BASE + 3]);   \
    unsigned b0 = cvtpk(P[BASE + 4], P[BASE + 5]), b1 = cvtpk(P[BASE + 6], P[BASE + 7]);                              \
    auto r0 = __builtin_amdgcn_permlane32_swap(a0, b0, false, false); auto r1 = __builtin_amdgcn_permlane32_swap(a1, b1, false, false); \
    u32x4 w = {r0[0], r1[0], r0[1], r1[1]}; OUT = *reinterpret_cast<bf16x8*>(&w); } while (0)
  PK4(p0, 0, pa0); PK4(p0, 8, pa1); PK4(p1, 0, pa2); PK4(p1, 8, pa3);
#undef PK4
}
__device__ __forceinline__ void qkt(f32x16& p0, f32x16& p1, const int (&ka)[4], int slot_off, const bf16x8* qr) {
  constexpr int PD = 2;
  bf16x8 kf0[12], kf1[12]; int kb[4];
#pragma unroll
  for (int jj = 0; jj < 4; ++jj) kb[jj] = ka[jj] + slot_off;
  p0 = f32x16{}; p1 = f32x16{};
#define QK_ISSUE(s) do { \
    asm volatile("ds_read_b128 %0, %1 offset:%c2" : "=v"(kf0[s]) : "v"(kb[(s) & 3]), "i"(((s) >> 2) * 128) : "memory"); \
    asm volatile("ds_read_b128 %0, %1 offset:%c2" : "=v"(kf1[s]) : "v"(kb[(s) & 3]), "i"(((s) >> 2) * 128 + 12288) : "memory"); } while (0)
#pragma unroll
  for (int s = 0; s < PD; ++s) QK_ISSUE(s);
#pragma unroll
  for (int d0 = 0; d0 < 12; ++d0) {
    if (d0 + PD < 12) QK_ISSUE(d0 + PD);
    const int later = 2 * ((d0 + PD < 12 ? d0 + PD : 11) - d0);
    asm volatile("s_waitcnt lgkmcnt(%c2)" : "+v"(kf0[d0]), "+v"(kf1[d0]) : "i"(later));
    p0 = __builtin_amdgcn_mfma_f32_32x32x16_bf16(kf0[d0], qr[d0], p0, 0, 0, 0);
    p1 = __builtin_amdgcn_mfma_f32_32x32x16_bf16(kf1[d0], qr[d0], p1, 0, 0, 0);
  }
#undef QK_ISSUE
}
__device__ __forceinline__ void glds16(const void* gsrc, unsigned lds_dst) { unsigned keep;
  asm volatile("s_mov_b32 %0, m0\n\ts_mov_b32 m0, %2\n\ts_nop 0\n\tglobal_load_lds_dwordx4 %1, off\n\ts_mov_b32 m0, %0" : "=&s"(keep) : "v"(gsrc), "s"(lds_dst) : "memory"); }
__device__ __forceinline__ int v_st(int k, int c) { const int kk = (k & ~0xC) | ((k & 4) << 1) | ((k & 8) >> 1); return ((kk >> 3) * 4 + (c >> 5)) * 512 + ((kk & 7) * 32 + (c & 31)) * 2; }
__device__ __forceinline__ int v_rd_base(int lane) { return ((lane & 3) << 3) | (((lane >> 2) & 3) << 6) | (((lane >> 4) & 1) << 5) | (((lane >> 5) & 1) << 8); }
constexpr int v_rd_off(int d0, int ks, int half) { return d0 * 512 + ks * 4096 + half * 2048; }
template <int OFF> __device__ __forceinline__ s16x4 tr_read(int vb) {
  s16x4 r; asm volatile("ds_read_b64_tr_b16 %0, %1 offset:%2" : "=&v"(r) : "v"(vb), "i"(OFF) : "memory"); return r;
}
template <int KS> __device__ __forceinline__ void pv_ks(f32x16* o, int vb, bf16x8 pa) {
  const s16x4 l0 = tr_read<v_rd_off(0, KS, 0)>(vb), h0 = tr_read<v_rd_off(0, KS, 1)>(vb), l1 = tr_read<v_rd_off(1, KS, 0)>(vb), h1 = tr_read<v_rd_off(1, KS, 1)>(vb);
  const s16x4 l2 = tr_read<v_rd_off(2, KS, 0)>(vb), h2 = tr_read<v_rd_off(2, KS, 1)>(vb), l3 = tr_read<v_rd_off(3, KS, 0)>(vb), h3 = tr_read<v_rd_off(3, KS, 1)>(vb);
  asm volatile("s_waitcnt lgkmcnt(0)" ::: "memory"); SBAR();
#define PK(L, H) (bf16x8){L[0], L[1], L[2], L[3], H[0], H[1], H[2], H[3]}
  o[0] = __builtin_amdgcn_mfma_f32_32x32x16_bf16(pa, PK(l0, h0), o[0], 0, 0, 0);
  o[1] = __builtin_amdgcn_mfma_f32_32x32x16_bf16(pa, PK(l1, h1), o[1], 0, 0, 0);
  o[2] = __builtin_amdgcn_mfma_f32_32x32x16_bf16(pa, PK(l2, h2), o[2], 0, 0, 0);
  o[3] = __builtin_amdgcn_mfma_f32_32x32x16_bf16(pa, PK(l3, h3), o[3], 0, 0, 0);
#undef PK
}
__device__ __forceinline__ void pv_d0(f32x16* o, int vb, bf16x8 pa0, bf16x8 pa1, bf16x8 pa2, bf16x8 pa3) {
  pv_ks<0>(o, vb, pa0); pv_ks<1>(o, vb, pa1); pv_ks<2>(o, vb, pa2); pv_ks<3>(o, vb, pa3);
}

__device__ __forceinline__ void attn_unit(const bf16_t* __restrict__ Qh, const bf16_t* __restrict__ Kh, const bf16_t* __restrict__ Vh,
                                          const bf16_t* Gt, bf16_t* Ot  , int qb, char* lds,
                                          const float* __restrict__ gq, const float* __restrict__ cs_b, const float* __restrict__ sn_b) {
  int tid_l = threadIdx.x; asm volatile("" : "+v"(tid_l));
  const int tid = tid_l, wid = __builtin_amdgcn_readfirstlane(tid >> 6), lane = tid & 63, r32 = lane & 31, hi = lane >> 5;
  const unsigned lds0 = (unsigned)(uintptr_t)lds;
  float* ws = (float*)(lds + LDS_WSF) + wid * 64; float* li_l = ws; float* al_l = ws + 32;
  float m_reg = -1e30f, l_reg = 0; f32x16 o[4] = {}; bf16x8 qr[12];
  const int q0 = qb * 256;
  const bf16_t* Qw = Qh + (size_t)(q0 + wid * QBLK + r32) * QKH + hi * 8;
  int gko[3], gvo[2];
#pragma unroll
  for (int i = 0; i < 3; ++i) { const int q = (i * 8 + wid) * 64 + lane, row = q / 24, chs = q - row * 24, ch = chs ^ ((row >> 1) & 7); gko[i] = row * QKH + ch * 8; }
#pragma unroll
  for (int i = 0; i < 2; ++i) { const int q = (i * 8 + wid) * 64 + lane, st = q >> 5, kk = (st >> 2) * 8 + ((q & 31) >> 2), cc = (st & 3) * 32 + (q & 3) * 8;
    const int k = (kk & ~0xC) | ((kk & 4) << 1) | ((kk & 8) >> 1); gvo[i] = k * VH + cc; }
#define DMA_K(t, slot) do { _Pragma("unroll") for (int i_ = 0; i_ < 3; ++i_) glds16(Kh + (size_t)(t) * (KVBLK * QKH) + gko[i_], (unsigned)__builtin_amdgcn_readfirstlane(lds0 + LDS_KR + (slot) * SHM_K + (i_ * 8 + wid) * 1024)); } while (0)
#define DMA_V(t, slot) do { _Pragma("unroll") for (int i_ = 0; i_ < 2; ++i_) glds16(Vh + (size_t)(t) * (KVBLK * VH) + gvo[i_], (unsigned)__builtin_amdgcn_readfirstlane(lds0 + LDS_VR + (slot) * SHM_V + (i_ * 8 + wid) * 1024)); } while (0)
#define WAITBAR(N) asm volatile("s_waitcnt vmcnt(" #N ") lgkmcnt(0)\n\ts_barrier" ::: "memory")
  DMA_K(0, 0); DMA_V(0, 0); DMA_K(1, 1);
  {
    float xq[12][8]; float ss = 0.f;
#pragma unroll
    for (int d0 = 0; d0 < 12; ++d0) { const u32x4 w = __builtin_nontemporal_load(reinterpret_cast<const u32x4*>(Qw + d0 * 16));
      xq[d0][0] = bflo(w.x); xq[d0][1] = bfhi(w.x); xq[d0][2] = bflo(w.y); xq[d0][3] = bfhi(w.y); xq[d0][4] = bflo(w.z); xq[d0][5] = bfhi(w.z); xq[d0][6] = bflo(w.w); xq[d0][7] = bfhi(w.w);
#pragma unroll
      for (int k = 0; k < 8; ++k) ss += xq[d0][k] * xq[d0][k]; }
    { auto rr = __builtin_amdgcn_permlane32_swap(__float_as_uint(ss), __float_as_uint(ss), false, false); ss = __uint_as_float(rr[0]) + __uint_as_float(rr[1]); }
    const float rinv = 1.0f / sqrtf(ss * (1.0f / QKH) + EPS);
#pragma unroll
    for (int d0 = 0; d0 < 12; ++d0) { const f32x4 g0 = *(const f32x4*)(gq + d0 * 16 + hi * 8), g1 = *(const f32x4*)(gq + d0 * 16 + hi * 8 + 4);
#pragma unroll
      for (int k = 0; k < 4; ++k) { xq[d0][k] *= rinv * g0[k]; xq[d0][4 + k] *= rinv * g1[k]; } }
    const size_t trow = (size_t)(q0 + wid * QBLK + r32) * 32 + hi * 8;
#pragma unroll
    for (int p = 0; p < 2; ++p) { const f32x4 c0 = *(const f32x4*)(cs_b + trow + p * 16), c1 = *(const f32x4*)(cs_b + trow + p * 16 + 4), s0 = *(const f32x4*)(sn_b + trow + p * 16), s1 = *(const f32x4*)(sn_b + trow + p * 16 + 4);
#pragma unroll
      for (int k = 0; k < 8; ++k) { const float cc = k < 4 ? c0[k & 3] : c1[k & 3], sv = k < 4 ? s0[k & 3] : s1[k & 3]; const float a = xq[8 + p][k], b = xq[10 + p][k];
        xq[8 + p][k] = a * cc - b * sv; xq[10 + p][k] = b * cc + a * sv; } }
#pragma unroll
    for (int d0 = 0; d0 < 12; ++d0) { u32x4 w; w.x = cvtpk(xq[d0][0], xq[d0][1]); w.y = cvtpk(xq[d0][2], xq[d0][3]); w.z = cvtpk(xq[d0][4], xq[d0][5]); w.w = cvtpk(xq[d0][6], xq[d0][7]);
      qr[d0] = __builtin_bit_cast(bf16x8, w); }
  }
  int ka[4];
#pragma unroll
  for (int jj = 0; jj < 4; ++jj) ka[jj] = (int)(lds0 + LDS_KR) + r32 * 384 + (((2 * jj + hi) ^ ((r32 >> 1) & 7)) << 4);
  const int jmax = (q0 + wid * QBLK) >> 6;
  const int vb0 = (int)(lds0 + LDS_VR) + v_rd_base(lane);
#define RESC(a) do { if (__any((a) < 1.f)) { if (hi == 0) al_l[r32] = (a); asm volatile("s_waitcnt lgkmcnt(0)" ::: "memory"); \
    for (int d = 0; d < 4; ++d) for (int r = 0; r < 16; ++r) o[d][r] *= al_l[crow(r, hi)]; } } while (0)
  f32x16 pA0, pA1, pB0, pB1; float mnA, mnB, alA, alB; bf16x8 pa0, pa1, pa2, pa3; const int NT = (q0 + 256) / KVBLK;
  int s0 = 0, s1 = 1, s2 = 2;
#define ROT() do { const int t_ = s0; s0 = s1; s1 = s2; s2 = t_; } while (0)
  WAITBAR(0);
  DMA_K(2, s2); DMA_V(1, s1);
  qkt(pA0, pA1, ka, s0 * SHM_K, qr); partialSM(pA0, pA1, m_reg, mnA, alA, true);
  WAITBAR(5); ROT();
  for (int j = 1; j + 1 < NT; j += 2) {
    DMA_K(j + 2, s2); DMA_V(j + 1, s1);
    if (j <= jmax) { SBAR(); qkt(pB0, pB1, ka, s0 * SHM_K, qr); }
    if (j - 1 <= jmax) { finishSM(pA0, pA1, alA, l_reg, pa0, pa1, pa2, pa3); SBAR();
      pv_d0(o, vb0 + s2 * SHM_V, pa0, pa1, pa2, pa3); }
    if (j <= jmax) { partialSM(pB0, pB1, m_reg, mnB, alB, true); RESC(alB); }
    WAITBAR(5); ROT();
    const bool more = j + 3 < NT;
    if (more) DMA_K(j + 3, s2);
    DMA_V(j + 2, s1);
    if (j + 1 <= jmax) { SBAR(); qkt(pA0, pA1, ka, s0 * SHM_K, qr); }
    if (j <= jmax) { finishSM(pB0, pB1, alB, l_reg, pa0, pa1, pa2, pa3); SBAR();
      pv_d0(o, vb0 + s2 * SHM_V, pa0, pa1, pa2, pa3); }
    if (j + 1 <= jmax) { partialSM(pA0, pA1, m_reg, mnA, alA, true); RESC(alA); }
    if (more) WAITBAR(5); else WAITBAR(2);
    ROT();
  }
  if (NT - 1 <= jmax) { SBAR(); qkt(pB0, pB1, ka, s0 * SHM_K, qr); }
  if (NT - 2 <= jmax) { finishSM(pA0, pA1, alA, l_reg, pa0, pa1, pa2, pa3); SBAR();
    pv_d0(o, vb0 + s2 * SHM_V, pa0, pa1, pa2, pa3); }
  if (NT - 1 <= jmax) { partialSM(pB0, pB1, m_reg, mnB, alB, true); RESC(alB); }
  WAITBAR(0);
  if (NT - 1 <= jmax) { finishSM(pB0, pB1, alB, l_reg, pa0, pa1, pa2, pa3); SBAR();
    pv_d0(o, vb0 + s0 * SHM_V, pa0, pa1, pa2, pa3); }
  if (hi == 0) li_l[r32] = l_reg; asm volatile("s_waitcnt lgkmcnt(0)" ::: "memory");
  float rli[16];
#pragma unroll
  for (int r = 0; r < 16; ++r) rli[r] = __builtin_amdgcn_rcpf(li_l[crow(r, hi)]);
  const size_t rowb = (size_t)(q0 + wid * QBLK);
#pragma unroll
  for (int r = 0; r < 16; ++r) { const size_t off = (rowb + crow(r, hi)) * WB + r32;
#pragma unroll
    for (int d0 = 0; d0 < 4; ++d0) { const float g = __builtin_bit_cast(float, (unsigned)__builtin_nontemporal_load(Gt + off + d0 * 32) << 16);
      Ot[off + d0 * 32] = (bf16_t)f2bf(o[d0][r] * rli[r] * g); } }
  asm volatile("s_waitcnt lgkmcnt(0)\n\ts_barrier" ::: "memory");
#undef DMA_K
#undef DMA_V
#undef WAITBAR
#undef RESC
#undef ROT
}
#undef SBAR
}
struct Ctx { int tid, lane, wave, gw, ngw; LAS unsigned char* lds; };

__device__ __forceinline__ void transpose_item(const float* __restrict__ W, int K, int N, int ldw, bf16_t* __restrict__ WT, int row_off, const float* __restrict__ gain, LAS float* scr, int item, int lane) {
    const int nblk = N / 32, kb = item / nblk, nb = item % nblk, k0 = 64 * kb, n0 = 32 * nb;
    float wv[32];
    const float* wp = W + (size_t)(k0 + (lane >> 5)) * ldw + n0 + (lane & 31);
#pragma unroll
    for (int i = 0; i < 32; ++i) wv[i] = __builtin_nontemporal_load(wp + (size_t)(2 * i) * ldw);
    if (gain) {
#pragma unroll
        for (int i = 0; i < 32; ++i) wv[i] *= gain[k0 + 2 * i + (lane >> 5)];
    }
#pragma unroll
    for (int i = 0; i < 32; ++i) scr[(2 * i + (lane >> 5)) * 33 + (lane & 31)] = wv[i];
    asm volatile("s_waitcnt lgkmcnt(0)" ::: "memory");
    const int c = lane & 7;
#pragma unroll
    for (int j = 0; j < 4; ++j) { const int n = (lane >> 3) + 8 * j; const LAS float* s = scr + (8 * c) * 33 + n;
        u32x4 o; o.x = pk2(s[0 * 33], s[1 * 33]); o.y = pk2(s[2 * 33], s[3 * 33]); o.z = pk2(s[4 * 33], s[5 * 33]); o.w = pk2(s[6 * 33], s[7 * 33]);
        *(u32x4*)(WT + (size_t)(row_off + n0 + n) * K + k0 + 8 * c) = o; }
    asm volatile("s_waitcnt lgkmcnt(0)" ::: "memory");
}
__device__ __forceinline__ void convert_weight(const Ctx& c, const float* W, int K, int N, bf16_t* WT, int row_off, const float* gain, int ldw = 0) {
    LAS float* scr = (LAS float*)(c.lds + c.wave * 16384);
    const int nitems = (K / 64) * (N / 32);
    for (int it = c.gw; it < nitems; it += c.ngw) transpose_item(W, K, N, ldw ? ldw : N, WT, row_off, gain, scr, it, c.lane);
}
__device__ __forceinline__ void convert_plain(const Ctx& c, const float* __restrict__ W, int K, int ncols, int ldw, bf16_t* __restrict__ out, int ldo, int coff, const float* __restrict__ gain) {
    const int per_row = ncols / 8, total = K * per_row, stride = c.ngw * 64;
    for (int i0 = c.gw * 64 + c.lane; i0 < total; i0 += 4 * stride) {
        f32x4 a[4], b[4]; int kk[4], cc[4];
#pragma unroll
        for (int u = 0; u < 4; ++u) { const int i = i0 + u * stride; const bool ok = i < total; const int ii = ok ? i : i0; kk[u] = ii / per_row; cc[u] = (ii - kk[u] * per_row) * 8;
            a[u] = __builtin_nontemporal_load((const f32x4*)(W + (size_t)kk[u] * ldw + cc[u])); b[u] = __builtin_nontemporal_load((const f32x4*)(W + (size_t)kk[u] * ldw + cc[u] + 4)); }
#pragma unroll
        for (int u = 0; u < 4; ++u) { if (i0 + u * stride < total) { const float g = gain[kk[u]]; *(u32x4*)(out + (size_t)kk[u] * ldo + coff + cc[u]) = pack8(a[u] * g, b[u] * g); } }
    }
}
__device__ __forceinline__ void xprep_rows(const Ctx& c, const float* __restrict__ x, bf16_t* __restrict__ xb, float* __restrict__ ssq) {
    for (int r = c.gw; r < MTOK; r += c.ngw) {
        const f32x4* xr = (const f32x4*)(x + (size_t)r * DM) + c.lane;
        f32x4 v[8]; float s = 0.f;
#pragma unroll
        for (int j = 0; j < 8; ++j) { v[j] = __builtin_nontemporal_load(xr + 64 * j); s += (v[j].x * v[j].x + v[j].y * v[j].y) + (v[j].z * v[j].z + v[j].w * v[j].w); }
        s = wave_sum(s);
        if (c.lane == 0) ssq[r] = s;
        u32x2* o = (u32x2*)(xb + (size_t)r * DM) + c.lane;
#pragma unroll
        for (int j = 0; j < 8; ++j) { u32x2 w; w.x = pk2(v[j].x, v[j].y); w.y = pk2(v[j].z, v[j].w); o[64 * j] = w; }
    }
}
__device__ __forceinline__ void rope_tables(const Ctx& c, const int* __restrict__ pos, float* __restrict__ cs, float* __restrict__ sn) {
    const int gt = c.gw * 64 + c.lane, ngt = c.ngw * 64;
    for (int i = gt; i < MTOK * 32; i += ngt) {
        const int t = i >> 5, f = i & 31;
        const float inv = exp2f(-(float)f * 0.41524101186092029f);
        const float ang = (float)pos[t] * inv;
        float sd, cd; sincosf(ang, &sd, &cd);
        cs[i] = cd; sn[i] = sd;
    }
}
__device__ __forceinline__ void load8(const bf16_t* p, float* f) { const u32x4 w = __builtin_nontemporal_load((const u32x4*)p); f[0] = bflo(w.x); f[1] = bfhi(w.x); f[2] = bflo(w.y); f[3] = bfhi(w.y); f[4] = bflo(w.z); f[5] = bfhi(w.z); f[6] = bflo(w.w); f[7] = bfhi(w.w); }
__device__ __forceinline__ void pool_phase(const Ctx& c, const bf16_t* __restrict__ U, bf16_t* __restrict__ P, const bf16_t* __restrict__ G, const float* __restrict__ scale) {
    constexpr int SEGL = 64, NSEG = MTOK / SEGL;
    for (int seg = blockIdx.x; seg < NSEG; seg += gridDim.x) {
        const int t0 = seg * SEGL, s0 = t0 & (SEQ - 1), col = c.tid * 8, w = 2 << (col >> 10);
        const bf16_t* Uc = U + col; bf16_t* Pc = P + col; const bf16_t* Gc = G + col;
        float sc[8];
#pragma unroll
        for (int k = 0; k < 8; ++k) sc[k] = scale[col + k];
        float sum[8];
#pragma unroll
        for (int k = 0; k < 8; ++k) sum[k] = 0.f;
        for (int i = 1; i <= w; ++i) { if (s0 - i >= 0) { float f[8]; load8(Uc + (size_t)(t0 - i) * WA, f);
#pragma unroll
            for (int k = 0; k < 8; ++k) sum[k] += f[k]; } }
        const float rw = 1.0f / (float)w;
#pragma unroll 4
        for (int i = 0; i < SEGL; ++i) {
            const int t = t0 + i, s = s0 + i; float f[8], old[8];
            load8(Uc + (size_t)t * WA, f);
            if (s >= w) load8(Uc + (size_t)(t - w) * WA, old); else {
#pragma unroll
                for (int k = 0; k < 8; ++k) old[k] = 0.f; }
            const float rc = (s + 1 < w) ? 1.0f / (float)(s + 1) : rw;
            float o[8], gt[8]; load8(Gc + (size_t)t * WA, gt);
#pragma unroll
            for (int k = 0; k < 8; ++k) { sum[k] += f[k] - old[k]; o[k] = (sum[k] * rc - f[k]) * sc[k] * gt[k]; }
            u32x4 pw; pw.x = pk2(o[0], o[1]); pw.y = pk2(o[2], o[3]); pw.z = pk2(o[4], o[5]); pw.w = pk2(o[6], o[7]);
            *(u32x4*)(Pc + (size_t)t * WA) = pw;
        }
    }
}
template <bool ISK>
__device__ __forceinline__ void qknorm_rope(const Ctx& c, bf16_t* __restrict__ T, const float* __restrict__ KR, const float* __restrict__ g, const float* __restrict__ cs, const float* __restrict__ sn) {
    const int l = c.lane & 7, sub = c.lane >> 3;
    float gn[16], g1[4], g2[4];
#pragma unroll
    for (int k = 0; k < 16; ++k) gn[k] = g[16 * l + k];
#pragma unroll
    for (int k = 0; k < 4; ++k) { g1[k] = g[128 + 4 * l + k]; g2[k] = g[160 + 4 * l + k]; }
    const int nvec = MTOK * NH;
    for (int v = c.gw * 8 + sub; v < nvec; v += c.ngw * 8) {
        const int s = v & (SEQ - 1), bh = v >> 12, tok = (bh >> 4) * SEQ + s;
        bf16_t* p = T + (size_t)v * QKH;
        float x[16], t1[4], t2[4];
        load8(p + 16 * l, x); load8(p + 16 * l + 8, x + 8);
        if (ISK) { const f32x4 a = *(const f32x4*)(KR + (size_t)tok * 64 + 4 * l), b = *(const f32x4*)(KR + (size_t)tok * 64 + 32 + 4 * l);
#pragma unroll
            for (int k = 0; k < 4; ++k) { t1[k] = a[k]; t2[k] = b[k]; } }
        else { const u32x2 a = *(const u32x2*)(p + 128 + 4 * l), b = *(const u32x2*)(p + 160 + 4 * l);
            t1[0] = bflo(a.x); t1[1] = bfhi(a.x); t1[2] = bflo(a.y); t1[3] = bfhi(a.y); t2[0] = bflo(b.x); t2[1] = bfhi(b.x); t2[2] = bflo(b.y); t2[3] = bfhi(b.y); }
        float ss = 0.f;
#pragma unroll
        for (int k = 0; k < 16; ++k) ss += x[k] * x[k];
#pragma unroll
        for (int k = 0; k < 4; ++k) ss += t1[k] * t1[k] + t2[k] * t2[k];
        ss += __shfl_xor(ss, 1); ss += __shfl_xor(ss, 2); ss += __shfl_xor(ss, 4);
        const float rinv = 1.0f / sqrtf(ss * (1.0f / QKH) + EPS);
        const f32x4 cc = *(const f32x4*)(cs + (size_t)tok * 32 + 4 * l), sv = *(const f32x4*)(sn + (size_t)tok * 32 + 4 * l);
        u32x4 w0, w1;
#pragma unroll
        for (int k = 0; k < 16; ++k) x[k] *= rinv * gn[k];
        w0.x = pk2(x[0], x[1]); w0.y = pk2(x[2], x[3]); w0.z = pk2(x[4], x[5]); w0.w = pk2(x[6], x[7]);
        w1.x = pk2(x[8], x[9]); w1.y = pk2(x[10], x[11]); w1.z = pk2(x[12], x[13]); w1.w = pk2(x[14], x[15]);
        float o1[4], o2[4];
#pragma unroll
        for (int k = 0; k < 4; ++k) { const float a = t1[k] * rinv * g1[k], b = t2[k] * rinv * g2[k]; o1[k] = a * cc[k] - b * sv[k]; o2[k] = b * cc[k] + a * sv[k]; }
        *(u32x4*)(p + 16 * l) = w0; *(u32x4*)(p + 16 * l + 8) = w1;
        u32x2 r1, r2; r1.x = pk2(o1[0], o1[1]); r1.y = pk2(o1[2], o1[3]); r2.x = pk2(o2[0], o2[1]); r2.y = pk2(o2[2], o2[3]);
        *(u32x2*)(p + 128 + 4 * l) = r1; *(u32x2*)(p + 160 + 4 * l) = r2;
    }
}
struct Args { const void* in[18]; float* out; unsigned char* ws; };
enum { I_X = 0, I_POS, I_ANG, I_AWIN, I_AWG, I_ASC, I_AWOUT, I_KVNG, I_KVWA, I_KVLG, I_KVWB, I_KNG, I_BNG, I_BWIN, I_BQLG, I_BWQB, I_BQNG, I_BWOUT };

#define GEMM_RUN_M(EPI, M_, gA, gB, N_, K_, LDA, LDB, AGD, AGS, BGD, BGS, ...) do { \
    pg8::Gemm g_{(const bf16_t*)(gA), (const bf16_t*)(gB), (M_), (N_), (K_), (LDA), (LDB), (AGD), (AGS), (BGD), (BGS)}; pg8::StaticOrder S_; S_.init((M_), (N_), (int)gridDim.x, (int)blockIdx.x); \
    EPI E_{__VA_ARGS__}; pg8::gemm_phase<EPI, pg8::StaticOrder, EPI::ALIGN, true>(c.lds, g_, S_, E_); } while (0)
#define GEMM_RUN(EPI, gA, gB, N_, K_, LDA, LDB, AGD, AGS, ...) GEMM_RUN_M(EPI, MTOK, gA, gB, N_, K_, LDA, LDB, AGD, AGS, NOGRP, 0, __VA_ARGS__)
constexpr int NOGRP = 1 << 30;

typedef const __attribute__((address_space(4))) Args* ArgsP;
__device__ __forceinline__ ArgsP get_args() { auto p = __builtin_amdgcn_kernarg_segment_ptr(); asm volatile("" : "+s"(p)); return (ArgsP)p; }
__device__ __forceinline__ Ctx make_ctx(unsigned char* lds_raw) {
    Ctx c; int tid = threadIdx.x; asm volatile("" : "+v"(tid)); c.tid = tid; c.lane = tid & 63; c.wave = __builtin_amdgcn_readfirstlane(tid >> 6); c.gw = blockIdx.x * 8 + c.wave; c.ngw = gridDim.x * 8; c.lds = (LAS unsigned char*)lds_raw; return c;
}
#define PHASE_BEGIN ArgsP ap = get_args(); unsigned char* ws = ap->ws; const Ctx c = make_ctx(lds_raw); (void)ws; (void)c;
#define INF(k) ((const float*)ap->in[k])
#define WSB(off) ((bf16_t*)(ws + (off)))
#define WSF(off) ((float*)(ws + (off)))

#define GRID_BAR() do { ArgsP ap_ = get_args(); XcdBarrier b_; b_.bar = (unsigned*)(ap_->ws + WS_BAR); b_.x = xb_xcc_id(); b_.st = (volatile LAS unsigned*)((LAS unsigned char*)lds_raw + MISC_OFF); xcd_barrier(b_); } while (0)

__global__ void __launch_bounds__(512, 2) yoco_fwd(Args a_unused) {
    extern __shared__ __attribute__((aligned(16))) unsigned char lds_raw[];
    cg::grid_group grid = cg::this_grid();
    if (threadIdx.x < 2) ((LAS unsigned*)((LAS unsigned char*)lds_raw + MISC_OFF))[threadIdx.x] = 0u;
    { ArgsP ap_ = get_args(); if (threadIdx.x == 0) (void)xb_add((unsigned*)(ap_->ws + WS_BAR) + XB_XCNT(xb_xcc_id()), 1u); }
    __syncthreads();

    {
        PHASE_BEGIN
        rope_tables(c, (const int*)ap->in[I_POS], WSF(WS_COS), WSF(WS_SIN));
        { float* z = WSF(WS_SSQC); for (int i = c.gw * 64 + c.lane; i < 3 * MTOK; i += c.ngw * 64) z[i] = 0.f; }
        { float* z = WSF(WS_SSQX) + MTOK; for (int i = c.gw * 64 + c.lane; i < 4 * MTOK; i += c.ngw * 64) z[i] = 0.f; }
        xprep_rows(c, INF(I_X), (bf16_t*)ap->out, WSF(WS_SSQX));
#pragma unroll 1
        for (int l = 0; l < 2; ++l) {
            const float* win = INF(I_AWIN) + (size_t)l * DM * 2 * WA; const float* gl = INF(I_ANG) + l * DM;
#pragma unroll 1
            for (int g = 0; g < 4; ++g) convert_weight(c, INF(I_AWG) + ((size_t)l * 4 + g) * GA * GA, GA, GA, WSB(WS_AWGB), l * WA + g * GA, nullptr);
            convert_plain(c, win, DM, WA, 2 * WA, WSB(WS_WINUB), 2 * WA, l * WA, gl);
            convert_weight(c, win + WA, DM, WA, WSB(l ? WS_A1WIN : WS_AWIN), WA, gl, 2 * WA);
            convert_weight(c, INF(I_AWOUT) + (size_t)l * WA * DM, WA, DM, WSB(l ? WS_A1WOUT : WS_AWOUT), 0, nullptr);
        }
    }
    if (gridDim.x == 0x7fffffffu) grid.sync();
    GRID_BAR();
    {
        PHASE_BEGIN
        GEMM_RUN_M(EpiWp, 2 * WA, WSB(WS_AWGB), WSB(WS_WINUB), DM, GA, GA, 2 * WA, NOGRP, 0, 4, GA, WSB(WS_AWIN), WSB(WS_A1WIN));
    }
    GRID_BAR();
#pragma unroll 1
    for (int l = 0; l < 2; ++l) {
        {
            PHASE_BEGIN
            GEMM_RUN(EpiA1, (bf16_t*)ap->out + (size_t)l * MTOK * DM, WSB(l ? WS_A1WIN : WS_AWIN), 2 * WA, DM, DM, DM, NOGRP, 0, WSB(l ? WS_R0 : WS_R1), WSB(WS_G), WSF(WS_SSQX) + l * MTOK);
        }
        GRID_BAR();
        {
            PHASE_BEGIN
            pool_phase(c, WSB(l ? WS_R0 : WS_R1), WSB(l ? WS_R1 : WS_R0), WSB(WS_G), INF(I_ASC) + l * WA);
            if (l == 1) {
                bf16_t* WC0 = WSB(WS_BWC0);
                convert_weight(c, INF(I_KVWA), DM, KVL + QKR, WC0, 0, INF(I_KVNG));
                { u32x4* z = (u32x4*)(WC0 + (size_t)(KVL + QKR) * DM); const int n16 = 192 * DM * 2 / 16; for (int i = c.gw * 64 + c.lane; i < n16; i += c.ngw * 64) z[i] = (u32x4){0u, 0u, 0u, 0u}; }
                convert_weight(c, INF(I_BWIN), DM, QL_ + WB, WC0, 768, INF(I_BNG));
            }
        }
        GRID_BAR();
        {
            PHASE_BEGIN
            GEMM_RUN(EpiRes, WSB(l ? WS_R1 : WS_R0), WSB(l ? WS_A1WOUT : WS_AWOUT), DM, WA, WA, WA, NOGRP, 0, (const bf16_t*)ap->out + (size_t)l * MTOK * DM, (float*)nullptr, (bf16_t*)ap->out + (size_t)(1 - l) * MTOK * DM, WSF(WS_SSQX) + (l + 1) * MTOK);
        }
        GRID_BAR();
    }
#pragma unroll 1
    for (int j = 0; j < 2; ++j) {
        {
            PHASE_BEGIN
            float* ssqq = WSF(j ? WS_SSQQ1 : WS_SSQQ0);
            GEMM_RUN(EpiBin, (j ? WSB(WS_XB2) : (bf16_t*)ap->out), WSB(j ? WS_BWIN1 : WS_BWC0), j ? 2560 : 3328, DM, DM, DM, NOGRP, 0, WSB(WS_CB), WSB(WS_QL), WSB(WS_GB), WSF(WS_KR), WSF(WS_SSQC), ssqq, j ? 3 : 0, WSF(WS_SSQX) + (2 + j) * MTOK, WSF(WS_SSQKR));
        }
        {
            PHASE_BEGIN
            if (j == 0) {
                const int G_ = gridDim.x, nfull = (G_ == 256) ? 64 : 0;
                if ((int)blockIdx.x >= nfull) {
                    Ctx c2 = c; c2.gw = ((int)blockIdx.x - nfull) * 8 + c.wave; c2.ngw = (G_ - nfull) * 8;
                    convert_weight(c2, INF(I_BWIN) + (size_t)DM * (QL_ + WB), DM, QL_ + WB, WSB(WS_BWIN1), 0, INF(I_BNG) + DM);
                    convert_weight(c2, INF(I_KVWB), KVL, NH * (QKN + VH), WSB(WS_BWKVB), 0, INF(I_KVLG));
#pragma unroll 1
                    for (int jj = 0; jj < 2; ++jj) {
                        convert_weight(c2, INF(I_BWQB) + (size_t)jj * QL_ * NH * QKH, QL_, NH * QKH, WSB(jj ? WS_BWQB1 : WS_BWQB0), 0, INF(I_BQLG) + jj * QL_);
                        convert_weight(c2, INF(I_BWOUT) + (size_t)jj * WB * DM, WB, DM, WSB(jj ? WS_BWO1 : WS_BWO0), 0, nullptr);
                    }
                }
            }
        }
        GRID_BAR();
        if (j == 0) {
            PHASE_BEGIN
            GEMM_RUN(EpiKVb, WSB(WS_CB), WSB(WS_BWKVB), NH * (QKN + VH), KVL, KVL, KVL, NOGRP, 0, WSB(WS_K), WSB(WS_V), WSF(WS_SSQC), WSF(WS_SSQKR), WSF(WS_KR), INF(I_KNG), WSF(WS_COS), WSF(WS_SIN), (LAS float*)(c.lds + XCH_OFF));
        }
        {
            PHASE_BEGIN
            GEMM_RUN(EpiQb, WSB(WS_QL), WSB(j ? WS_BWQB1 : WS_BWQB0), NH * QKH, QL_, QL_, QL_, NOGRP, 0, WSB(WS_Q), WSF(j ? WS_SSQQ1 : WS_SSQQ0));
        }
        GRID_BAR();
        {
            PHASE_BEGIN
            const int G_ = gridDim.x, bx = blockIdx.x; const int vcu = (G_ % 8 == 0) ? (bx % 8) * (G_ / 8) + bx / 8 : bx;
#pragma unroll 1
            for (int slot = vcu; slot < 256; slot += G_) {
                const int bh = slot >> 2, s = slot & 3, b = bh >> 4, h = bh & 15;
#pragma unroll 1
                for (int i = 0; i < 4; ++i) {
                    const int qb = (i == 0) ? 15 - s : (i == 1) ? 8 + s : (i == 2) ? 7 - s : s;
                    att::attn_unit(WSB(WS_Q) + (size_t)bh * SEQ * QKH, WSB(WS_K) + (size_t)bh * SEQ * QKH, WSB(WS_V) + (size_t)bh * SEQ * VH,
                                   WSB(WS_GB) + (size_t)b * SEQ * WB + h * VH, WSB(WS_OG) + (size_t)b * SEQ * WB + h * VH, qb, (char*)lds_raw,
                                   INF(I_BQNG) + j * QKH, WSF(WS_COS) + (size_t)b * SEQ * 32, WSF(WS_SIN) + (size_t)b * SEQ * 32);
                }
            }
        }
        GRID_BAR();
        {
            PHASE_BEGIN
            GEMM_RUN(EpiRes, WSB(WS_OG), WSB(j ? WS_BWO1 : WS_BWO0), DM, WB, WB, WB, NOGRP, 0, (j ? (const bf16_t*)WSB(WS_XB2) : (const bf16_t*)ap->out), (j ? ap->out : (float*)nullptr), (j == 0 ? WSB(WS_XB2) : (bf16_t*)nullptr), WSF(WS_SSQX) + 3 * MTOK);
        }
        if (j == 0) GRID_BAR();
    }
}

extern "C" void kernel_launch(void* const* d_in, const int* in_sizes, int n_in, void* d_out, int out_size, void* d_ws, size_t ws_size, hipStream_t stream) {
    static int grid_blocks = 0;
    if (grid_blocks == 0) {
        if (n_in != 18 || out_size != MTOK * DM || ws_size < WS_END) { fprintf(stderr, "kernel_launch: unexpected shapes n_in %d out %d ws %zu (need %zu)\n", n_in, out_size, ws_size, (size_t)WS_END); grid_blocks = -1; return; }
        int dev = 0, cus = 0, per_cu = 0;
        (void)hipGetDevice(&dev); (void)hipDeviceGetAttribute(&cus, hipDeviceAttributeMultiprocessorCount, dev);
        if (hipFuncSetAttribute((const void*)yoco_fwd, hipFuncAttributeMaxDynamicSharedMemorySize, LDS_BYTES) != hipSuccess) { fprintf(stderr, "kernel_launch: hipFuncSetAttribute failed\n"); grid_blocks = -1; return; }
        if (hipOccupancyMaxActiveBlocksPerMultiprocessor(&per_cu, (const void*)yoco_fwd, 512, LDS_BYTES) != hipSuccess || per_cu < 1) { fprintf(stderr, "kernel_launch: occupancy query gave %d\n", per_cu); per_cu = 1; }
        (void)hipGetLastError();
        grid_blocks = cus * 1;
        fprintf(stderr, "kernel_launch: cus %d per_cu %d grid %d ws %zu\n", cus, per_cu, grid_blocks, ws_size);
    }
    if (grid_blocks < 0) return;
    if (hipMemsetAsync((char*)d_ws + WS_BAR, 0, XCD_BAR_WORDS * 4, stream) != hipSuccess) { fprintf(stderr, "kernel_launch: hipMemsetAsync failed\n"); return; }
    Args a{};
    for (int i = 0; i < 18; ++i) a.in[i] = d_in[i];
    a.out = (float*)d_out; a.ws = (unsigned char*)d_ws;
    void* args[] = {&a};
    hipError_t e = hipLaunchCooperativeKernel((const void*)yoco_fwd, dim3(grid_blocks), dim3(512), args, LDS_BYTES, stream);
    if (e != hipSuccess) fprintf(stderr, "cooperative launch failed: %s (grid %d)\n", hipGetErrorString(e), grid_blocks);
}
```

```cpp
#include <hip/hip_runtime.h>
#include <hip/hip_cooperative_groups.h>
#include <hip/hip_bf16.h>
#include <cstdio>
#include <cstdint>
namespace cg = cooperative_groups;

namespace pg8 {
#define PG8_LAS __attribute__((address_space(3)))
typedef unsigned short bf16_t;
typedef short bf16x8 __attribute__((ext_vector_type(8)));
typedef float f32x4 __attribute__((ext_vector_type(4)));
typedef unsigned u32x4 __attribute__((ext_vector_type(4)));
constexpr int BM = 256, BK = 64, HALF = 128, HTB = HALF * BK * 2  , STAGE_BYTES = 8 * HTB, NXCD = 8, WGM = 8;

__host__ __device__ __forceinline__ int lds_byte(int r, int c) { const int st = (r >> 4) * 2 + (c >> 5), rr = r & 15, cc = c & 31, ob = rr * 64 + cc * 2; return st * 1024 + (ob ^ (((ob >> 9) & 1) << 5)); }
__host__ __device__ __forceinline__ void stage_rc(int b, int& R, int& C) { const int st = b / 1024, sb = b % 1024, swz = sb ^ (((sb >> 9) & 1) << 5); R = (st >> 1) * 16 + swz / 64; C = (st & 1) * 32 + (swz % 64) / 2; }
__host__ __device__ __forceinline__ int perm32(int rho) { const int n = rho >> 4, i = rho & 15; return 8 * (i >> 2) + 4 * n + (i & 3); }

struct Unit { int pm, pn; };
struct Gemm { const bf16_t* A; const bf16_t* Bt; int M, N, K, lda, ldb, agdiv, agstep, bgdiv, bgstep; };

struct StaticOrder {
    int nM, nN, nwg, G, c;
    __host__ __device__ void init(int M, int N, int G_, int c_) { nM = M / BM; nN = N / BM; nwg = nM * nN; G = G_; c = c_; }
    __host__ __device__ bool next(int i, Unit& u) const {
        const long L = (long)i * G + c; if (L >= nwg) return false;
        int wgid = (int)L; { const int q = nwg / NXCD, r = nwg % NXCD, xcd = wgid % NXCD, off = wgid / NXCD; wgid = (xcd < r ? xcd * (q + 1) : r * (q + 1) + (xcd - r) * q) + off; }
        const int nig = WGM * nN, gid = wgid / nig, fm = gid * WGM, gsz = (nM - fm) < WGM ? (nM - fm) : WGM;
        u.pm = fm + ((wgid % nig) % gsz); u.pn = (wgid % nig) / gsz; return true;
    }
    __device__ __forceinline__ void a_ready(const Unit&) const {}
    __device__ __forceinline__ void done(const Unit&) const {}
};

#define PG8_UA(u) ((const char*)g.A + (size_t)(u).pm * tstepA + (size_t)((u).pn / g.agdiv) * (size_t)g.agstep * 2)
#define PG8_UB(u) ((const char*)g.Bt + (size_t)(u).pn * tstepB + (size_t)((u).pm / g.bgdiv) * (size_t)g.bgstep * 2)
template <class Epi, class Sched, bool ALIGN_EPI = false, bool SP2 = false>
__device__ __forceinline__ void gemm_phase(PG8_LAS unsigned char* lds, const Gemm g, const Sched& S, const Epi& E) {
    int tid_l = threadIdx.x; asm volatile("" : "+v"(tid_l));
    const int tid = tid_l, wid = __builtin_amdgcn_readfirstlane(tid >> 6), lane = tid & 63, wr = wid >> 2, wc = wid & 3, fr = lane & 15, fq = lane >> 4;
    const int K = g.K, nt = K / BK;
    unsigned voffA[2], voffB[2];
#pragma unroll
    for (int i = 0; i < 2; ++i) { int R, C; stage_rc(tid * 16 + i * 8192, R, C); const int Rb = Epi::PERM ? ((R & ~31) + perm32(R & 31)) : R;
        voffA[i] = (unsigned)(R * g.lda + C) * 2u; voffB[i] = (unsigned)(Rb * g.ldb + C) * 2u; }
    const size_t kstep = (size_t)(BK * 2);
    const size_t hstepA = (size_t)HALF * g.lda * 2, hstepB = (size_t)HALF * g.ldb * 2;
    const size_t tstepA = 2 * hstepA, tstepB = 2 * hstepB;
    const unsigned ldsw = (unsigned)wid * 1024u;
    const int aoff = lds_byte(wr * 64 + fr, fq * 8), boff = lds_byte(wc * 32 + fr, fq * 8);
#define PG8_SA(b, h) (((b) * 2 + (h)) * HTB)
#define PG8_SB(b, h) ((4 + (b) * 2 + (h)) * HTB)
#define PG8_STAGE(bufoff, gbase, voff) do { _Pragma("unroll") for (int _i = 0; _i < 2; ++_i) \
        __builtin_amdgcn_global_load_lds((const unsigned*)((const char*)(gbase) + (voff)[_i]), (PG8_LAS unsigned*)(lds + (bufoff) + ldsw + _i * 8192), 16, 0, 0); } while (0)
#define PG8_LDA(dst, b, h) do { _Pragma("unroll") for (int m = 0; m < 4; ++m) _Pragma("unroll") for (int k = 0; k < 2; ++k) dst[m][k] = *(const PG8_LAS bf16x8*)(lds + PG8_SA(b, h) + aoff + m * 2048 + k * 1024); } while (0)
#define PG8_LDB(dst, b, h) do { _Pragma("unroll") for (int n = 0; n < 2; ++n) _Pragma("unroll") for (int k = 0; k < 2; ++k) dst[n][k] = *(const PG8_LAS bf16x8*)(lds + PG8_SB(b, h) + boff + n * 2048 + k * 1024); } while (0)
#define PG8_MMA(ai, bj, At, Bt) do { __builtin_amdgcn_s_setprio(1); _Pragma("unroll") for (int m = 0; m < 4; ++m) _Pragma("unroll") for (int n = 0; n < 2; ++n) _Pragma("unroll") for (int k = 0; k < 2; ++k) \
        acc[ai][bj][m][n] = __builtin_amdgcn_mfma_f32_16x16x32_bf16(Bt[n][k], At[m][k], acc[ai][bj][m][n], 0, 0, 0); __builtin_amdgcn_s_setprio(0); } while (0)
#define PG8_WAIT_V(n) asm volatile("s_waitcnt vmcnt(" #n ")" ::: "memory")
#define PG8_WAIT_L(n) asm volatile("s_waitcnt lgkmcnt(" #n ")" ::: "memory")
#define PG8_BAR __builtin_amdgcn_s_barrier()
#define PG8_SCHED __builtin_amdgcn_sched_barrier(0)
    Unit cur, nxt; int ui = 0;
    if (!S.next(0, cur)) return;
    f32x4 acc[2][2][4][2];
#pragma unroll
    for (int a = 0; a < 2; ++a)
#pragma unroll
        for (int b = 0; b < 2; ++b)
#pragma unroll
            for (int m = 0; m < 4; ++m)
#pragma unroll
                for (int n = 0; n < 2; ++n) acc[a][b][m][n] = (f32x4){0.f, 0.f, 0.f, 0.f};
    bf16x8 At[4][2], B0[2][2], B1[2][2];
    const char* cA = PG8_UA(cur); const char* cB = PG8_UB(cur);
    S.a_ready(cur);
    if constexpr (SP2) {
        PG8_STAGE(PG8_SB(0, 0), cB, voffB); PG8_STAGE(PG8_SB(0, 1), cB + hstepB, voffB); PG8_STAGE(PG8_SA(0, 0), cA, voffA); PG8_STAGE(PG8_SA(0, 1), cA + hstepA, voffA);
        if (wr == 1) PG8_BAR;
        PG8_WAIT_V(2); PG8_BAR;
        PG8_STAGE(PG8_SB(1, 0), cB + kstep, voffB); PG8_STAGE(PG8_SA(1, 0), cA + kstep, voffA); PG8_STAGE(PG8_SB(1, 1), cB + hstepB + kstep, voffB);
        PG8_WAIT_V(6); PG8_BAR;
    } else {
        PG8_STAGE(PG8_SB(0, 0), cB, voffB); PG8_STAGE(PG8_SA(0, 0), cA, voffA); PG8_STAGE(PG8_SB(0, 1), cB + hstepB, voffB); PG8_STAGE(PG8_SA(0, 1), cA + hstepA, voffA);
        if (wr == 1) PG8_BAR;
        PG8_WAIT_V(4); PG8_BAR;
        PG8_STAGE(PG8_SB(1, 0), cB + kstep, voffB); PG8_STAGE(PG8_SA(1, 0), cA + kstep, voffA); PG8_STAGE(PG8_SB(1, 1), cB + hstepB + kstep, voffB);
        PG8_WAIT_V(6); PG8_BAR;
    }
    for (;;) {
        const bool has_next = S.next(ui + 1, nxt);
        const char* nA = has_next ? PG8_UA(nxt) : cA; const char* nB = has_next ? PG8_UB(nxt) : cB;
        for (int t = 0; t < nt; t += 2) {
            const bool last = (t == nt - 2);
            const char* a1 = cA + (size_t)(t + 1) * kstep;
            const char* a2 = last ? nA : cA + (size_t)(t + 2) * kstep; const char* b2 = last ? nB : cB + (size_t)(t + 2) * kstep;
            const char* a3 = a2 + kstep; const char* b3 = b2 + kstep;
            if (last && has_next) S.a_ready(nxt);
            if constexpr (SP2) {
            PG8_LDB(B0, 0, 0); PG8_LDB(B1, 0, 1); PG8_SCHED; PG8_LDA(At, 0, 0); PG8_STAGE(PG8_SA(1, 1), a1 + hstepA, voffA);
            PG8_WAIT_V(8); PG8_WAIT_L(0); PG8_BAR; PG8_MMA(0, 0, At, B0); PG8_MMA(0, 1, At, B1); PG8_BAR; PG8_SCHED;
            PG8_LDA(At, 0, 1); PG8_STAGE(PG8_SB(0, 0), b2, voffB); PG8_STAGE(PG8_SB(0, 1), b2 + hstepB, voffB); PG8_STAGE(PG8_SA(0, 0), a2, voffA);
            PG8_WAIT_V(8); PG8_WAIT_L(0); PG8_BAR; PG8_MMA(1, 0, At, B0); PG8_MMA(1, 1, At, B1); PG8_BAR; PG8_SCHED;
            PG8_LDB(B0, 1, 0); PG8_LDB(B1, 1, 1); PG8_SCHED; PG8_LDA(At, 1, 0); PG8_STAGE(PG8_SA(0, 1), a2 + hstepA, voffA);
            PG8_WAIT_V(8); PG8_WAIT_L(0); PG8_BAR; PG8_MMA(0, 0, At, B0); PG8_MMA(0, 1, At, B1); PG8_BAR; PG8_SCHED;
            PG8_LDA(At, 1, 1); PG8_STAGE(PG8_SB(1, 0), b3, voffB); PG8_STAGE(PG8_SB(1, 1), b3 + hstepB, voffB); PG8_STAGE(PG8_SA(1, 0), a3, voffA);
            PG8_WAIT_V(8); PG8_WAIT_L(0); PG8_BAR; PG8_MMA(1, 0, At, B0); PG8_MMA(1, 1, At, B1); PG8_BAR; PG8_SCHED;
            } else {
            PG8_LDB(B0, 0, 0); PG8_SCHED; PG8_LDA(At, 0, 0); PG8_STAGE(PG8_SA(1, 1), a1 + hstepA, voffA);
            PG8_WAIT_L(8); PG8_BAR; PG8_WAIT_L(0); PG8_MMA(0, 0, At, B0); PG8_BAR; PG8_SCHED;
            PG8_LDB(B1, 0, 1); PG8_STAGE(PG8_SB(0, 0), b2, voffB);
            PG8_BAR; PG8_WAIT_L(0); PG8_MMA(0, 1, At, B1); PG8_BAR;
            PG8_LDA(At, 0, 1); PG8_STAGE(PG8_SA(0, 0), a2, voffA);
            PG8_BAR; PG8_WAIT_L(0); PG8_MMA(1, 0, At, B0); PG8_BAR; PG8_SCHED;
            PG8_STAGE(PG8_SB(0, 1), b2 + hstepB, voffB);
            PG8_WAIT_V(6); PG8_BAR; PG8_MMA(1, 1, At, B1); PG8_BAR;
            PG8_LDB(B0, 1, 0); PG8_SCHED; PG8_LDA(At, 1, 0); PG8_STAGE(PG8_SA(0, 1), a2 + hstepA, voffA);
            PG8_WAIT_L(8); PG8_BAR; PG8_WAIT_L(0); PG8_MMA(0, 0, At, B0); PG8_BAR; PG8_SCHED;
            PG8_LDB(B1, 1, 1); PG8_STAGE(PG8_SB(1, 0), b3, voffB);
            PG8_BAR; PG8_WAIT_L(0); PG8_MMA(0, 1, At, B1); PG8_BAR;
            PG8_LDA(At, 1, 1); PG8_STAGE(PG8_SA(1, 0), a3, voffA);
            PG8_BAR; PG8_WAIT_L(0); PG8_MMA(1, 0, At, B0); PG8_BAR; PG8_SCHED;
            PG8_STAGE(PG8_SB(1, 1), b3 + hstepB, voffB);
            PG8_WAIT_V(6); PG8_BAR; PG8_MMA(1, 1, At, B1); PG8_BAR;
            }
        }
        if constexpr (ALIGN_EPI) { if (wr == 0) PG8_BAR; }
        if constexpr (!Epi::AFTER_DRAIN) { E(acc, cur, wr, wc, fr, fq); S.done(cur); }
        if (!has_next) break;
#pragma unroll
        for (int a = 0; a < 2; ++a)
#pragma unroll
            for (int b = 0; b < 2; ++b)
#pragma unroll
                for (int m = 0; m < 4; ++m)
#pragma unroll
                    for (int n = 0; n < 2; ++n) acc[a][b][m][n] = (f32x4){0.f, 0.f, 0.f, 0.f};
        cur = nxt; cA = nA; cB = nB; ++ui;
        if constexpr (ALIGN_EPI) { if (wr == 1) PG8_BAR; }
    }
    PG8_WAIT_V(0);
    if constexpr (!ALIGN_EPI) { if (wr == 0) PG8_BAR; }
    PG8_BAR;
    if constexpr (Epi::AFTER_DRAIN) { E.fused(acc, cur, wr, wc, fr, fq, lds, wid, lane); S.done(cur); }
#undef PG8_SA
#undef PG8_SB
#undef PG8_STAGE
#undef PG8_LDA
#undef PG8_LDB
#undef PG8_MMA
#undef PG8_WAIT_V
#undef PG8_WAIT_L
#undef PG8_BAR
#undef PG8_SCHED
}
}

constexpr int DM = 2048, NB = 4, SEQ = 4096, MTOK = NB * SEQ;
constexpr int WA = 4096, GA = 1024, NH = 16, QKN = 128, QKR = 64, QKH = 192, VH = 128, KVL = 512, QL_ = 512, WB = 2048;
constexpr float EPS = 1e-6f;

typedef unsigned short bf16_t;
typedef float f32x4 __attribute__((ext_vector_type(4)));
typedef unsigned u32x4 __attribute__((ext_vector_type(4)));
typedef unsigned u32x2 __attribute__((ext_vector_type(2)));
typedef short bf16x8 __attribute__((ext_vector_type(8)));
#define LAS __attribute__((address_space(3)))

constexpr size_t MiB = 1u << 20;
constexpr size_t WS_COS = 0, WS_SIN = 2 * MiB, WS_SSQC = 4 * MiB, WS_SSQQ0 = 4 * MiB + 65536, WS_SSQQ1 = 4 * MiB + 131072, WS_SSQX = 4 * MiB + 196608  , WS_SSQKR = 4 * MiB + 458752  , WS_KR = 5 * MiB;
constexpr size_t WS_BAR = 9 * MiB;
constexpr size_t WS_W = 10 * MiB;
constexpr size_t WS_AWIN = WS_W, WS_AWG = WS_W + 32 * MiB, WS_AWOUT = WS_W + 40 * MiB;
constexpr size_t WS_BWC0 = WS_W, WS_BWIN1 = WS_W + 13 * MiB, WS_BWKVB = WS_W + 23 * MiB, WS_BWQB0 = WS_W + 27 * MiB, WS_BWQB1 = WS_W + 30 * MiB, WS_BWO0 = WS_W + 33 * MiB, WS_BWO1 = WS_W + 41 * MiB;
constexpr size_t WS_ACT = 66 * MiB;
constexpr size_t WS_XN = WS_ACT, WS_R0 = WS_ACT, WS_R1 = WS_ACT + 128 * MiB, WS_G = WS_ACT + 256 * MiB;
constexpr size_t WS_AWGB = WS_G, WS_WINUB = WS_G + 16 * MiB;
constexpr size_t WS_GB = WS_ACT + 64 * MiB, WS_OG = WS_GB  , WS_CB = WS_ACT + 128 * MiB, WS_QL = WS_ACT + 144 * MiB, WS_K = WS_ACT + 160 * MiB, WS_V = WS_ACT + 256 * MiB, WS_Q = WS_ACT + 320 * MiB;
constexpr size_t WS_W2 = 450 * MiB, WS_A1WIN = WS_W2, WS_A1WG = WS_W2 + 32 * MiB, WS_A1WOUT = WS_W2 + 40 * MiB;
constexpr size_t WS_XB2 = WS_ACT;
constexpr size_t WS_END = 506 * MiB;
constexpr int LDS_BYTES = 131072 + 8192, XCH_OFF = 131072  , MISC_OFF = 131072 + 4096;

__device__ __forceinline__ unsigned f2bf(float f) { unsigned u = __builtin_bit_cast(unsigned, f); return (u + 0x7fffu + ((u >> 16) & 1u)) >> 16; }
__device__ __forceinline__ unsigned pk2(float lo, float hi) { unsigned r; asm volatile("v_cvt_pk_bf16_f32 %0, %1, %2" : "=v"(r) : "v"(lo), "v"(hi)); return r; }
__device__ __forceinline__ float bflo(unsigned w) { return __builtin_bit_cast(float, w << 16); }
__device__ __forceinline__ float bfhi(unsigned w) { return __builtin_bit_cast(float, w & 0xffff0000u); }
__device__ __forceinline__ float silu_f(float v) { return v * __builtin_amdgcn_rcpf(1.0f + __builtin_amdgcn_exp2f(-1.4426950408889634f * v)); }
__device__ __forceinline__ float sum_fq(float v) {
    { auto rr = __builtin_amdgcn_permlane16_swap(__float_as_uint(v), __float_as_uint(v), false, false); v = __uint_as_float(rr[0]) + __uint_as_float(rr[1]); }
    { auto rr = __builtin_amdgcn_permlane32_swap(__float_as_uint(v), __float_as_uint(v), false, false); v = __uint_as_float(rr[0]) + __uint_as_float(rr[1]); }
    return v;
}
__device__ __forceinline__ float wave_sum(float v) {
#pragma unroll
    for (int o = 1; o < 64; o <<= 1) v += __shfl_xor(v, o);
    return v;
}

typedef const f32x4 (&AccT)[2][2][4][2];
#define EPI_ROWS(...) _Pragma("unroll") for (int ai = 0; ai < 2; ++ai) _Pragma("unroll") for (int m = 0; m < 4; ++m) { const int row = u.pm * 256 + ai * 128 + wr * 64 + m * 16 + fr; __VA_ARGS__ }
__device__ __forceinline__ u32x4 pack8(f32x4 a, f32x4 b) { u32x4 w; w.x = pk2(a[0], a[1]); w.y = pk2(a[2], a[3]); w.z = pk2(b[0], b[1]); w.w = pk2(b[2], b[3]); return w; }
__device__ __forceinline__ f32x4 silu4(f32x4 v) { return (f32x4){silu_f(v[0]), silu_f(v[1]), silu_f(v[2]), silu_f(v[3])}; }

struct EpiA1 {
    static constexpr bool PERM = true, AFTER_DRAIN = false, ALIGN = true;
    bf16_t* U; bf16_t* G; const float* ssqx;
    __device__ __forceinline__ void operator()(AccT acc, const pg8::Unit& u, int wr, int wc, int fr, int fq) const {
        const bool isg = u.pn >= 16; bf16_t* base = isg ? G : U; const int col0 = (isg ? u.pn - 16 : u.pn) * 256 + wc * 32 + fq * 8;
        EPI_ROWS(
            const float rx = 1.0f / sqrtf(ssqx[row] * (1.0f / DM) + EPS);
            _Pragma("unroll") for (int bj = 0; bj < 2; ++bj) { f32x4 v0 = acc[ai][bj][m][0] * rx, v1 = acc[ai][bj][m][1] * rx;
                if (isg) { v0 = silu4(v0); v1 = silu4(v1); }
                *(u32x4*)(base + (size_t)row * WA + col0 + bj * 128) = pack8(v0, v1); }
        )
    }
};
struct EpiWp {
    static constexpr bool PERM = true, AFTER_DRAIN = false, ALIGN = true;
    bf16_t* o0; bf16_t* o1;
    __device__ __forceinline__ void operator()(AccT acc, const pg8::Unit& u, int wr, int wc, int fr, int fq) const {
        const int col0 = u.pn * 256 + wc * 32 + fq * 8;
        EPI_ROWS(
            bf16_t* base = (row < WA ? o0 : o1) + (size_t)(row & (WA - 1)) * DM + col0;
            _Pragma("unroll") for (int bj = 0; bj < 2; ++bj) *(u32x4*)(base + bj * 128) = pack8(acc[ai][bj][m][0], acc[ai][bj][m][1]);
        )
    }
};
struct EpiRes {
    static constexpr bool PERM = true, AFTER_DRAIN = false, ALIGN = true;
    const bf16_t* res; float* out; bf16_t* xb; float* ssq;
    __device__ __forceinline__ void operator()(AccT acc, const pg8::Unit& u, int wr, int wc, int fr, int fq) const {
        const int col0 = u.pn * 256 + wc * 32 + fq * 8;
        EPI_ROWS(
            float s = 0.f;
            _Pragma("unroll") for (int bj = 0; bj < 2; ++bj) { const size_t off = (size_t)row * DM + col0 + bj * 128;
                const u32x4 rb = __builtin_nontemporal_load((const u32x4*)(res + off));
                const f32x4 r0 = (f32x4){bflo(rb.x), bfhi(rb.x), bflo(rb.y), bfhi(rb.y)} + acc[ai][bj][m][0], r1 = (f32x4){bflo(rb.z), bfhi(rb.z), bflo(rb.w), bfhi(rb.w)} + acc[ai][bj][m][1];
                if (out) { *(f32x4*)(out + off) = r0; *(f32x4*)(out + off + 4) = r1; }
                if (xb) { *(u32x4*)(xb + off) = pack8(r0, r1);
                    s += (r0[0] * r0[0] + r0[1] * r0[1]) + (r0[2] * r0[2] + r0[3] * r0[3]) + (r1[0] * r1[0] + r1[1] * r1[1]) + (r1[2] * r1[2] + r1[3] * r1[3]); } }
            if (xb) { s = sum_fq(s); if (fq == 0) atomicAdd(ssq + row, s); }
        )
    }
};
struct EpiBin {
    static constexpr bool PERM = true, AFTER_DRAIN = false, ALIGN = true;
    bf16_t* Cb; bf16_t* QL; bf16_t* Gb; float* KR; float* ssqc; float* ssqq; int toff; const float* ssqx; float* ssqkr;
    __device__ __forceinline__ void operator()(AccT acc, const pg8::Unit& u, int wr, int wc, int fr, int fq) const {
        const int t = u.pn + toff; const int cw = wc * 32 + fq * 8;
        if (t >= 5) {
            const int col0 = (t - 5) * 256 + cw;
            EPI_ROWS(
                const float rx = 1.0f / sqrtf(ssqx[row] * (1.0f / DM) + EPS);
                _Pragma("unroll") for (int bj = 0; bj < 2; ++bj)
                    *(u32x4*)(Gb + (size_t)row * WB + col0 + bj * 128) = pack8(silu4(acc[ai][bj][m][0] * rx), silu4(acc[ai][bj][m][1] * rx));
            )
        } else if (t == 2) {
            if (wc < 2) {
                EPI_ROWS(
                    const float rx = 1.0f / sqrtf(ssqx[row] * (1.0f / DM) + EPS);
                    const f32x4 v0 = acc[ai][0][m][0] * rx, v1 = acc[ai][0][m][1] * rx;
                    *(f32x4*)(KR + (size_t)row * 64 + cw) = v0; *(f32x4*)(KR + (size_t)row * 64 + cw + 4) = v1;
                    float s = (v0[0] * v0[0] + v0[1] * v0[1]) + (v0[2] * v0[2] + v0[3] * v0[3]) + (v1[0] * v1[0] + v1[1] * v1[1]) + (v1[2] * v1[2] + v1[3] * v1[3]);
                    s = sum_fq(s);
                    if (fq == 0) atomicAdd(ssqkr + row, s);
                )
            }
        } else {
            const bool isq = t >= 3; bf16_t* base = isq ? QL : Cb; float* ssq = isq ? ssqq : ssqc; const int col0 = (isq ? t - 3 : t) * 256 + cw;
            EPI_ROWS(
                float s = 0.f; const float rx = 1.0f / sqrtf(ssqx[row] * (1.0f / DM) + EPS);
                _Pragma("unroll") for (int bj = 0; bj < 2; ++bj) { const f32x4 v0 = acc[ai][bj][m][0] * rx, v1 = acc[ai][bj][m][1] * rx;
                    s += (v0[0] * v0[0] + v0[1] * v0[1]) + (v0[2] * v0[2] + v0[3] * v0[3]) + (v1[0] * v1[0] + v1[1] * v1[1]) + (v1[2] * v1[2] + v1[3] * v1[3]);
                    *(u32x4*)(base + (size_t)row * 512 + col0 + bj * 128) = pack8(v0, v1); }
                s = sum_fq(s);
                if (fq == 0) atomicAdd(ssq + row, s);
            )
        }
    }
};
struct EpiKVb {
    static constexpr bool PERM = true, AFTER_DRAIN = false, ALIGN = true;
    bf16_t* K; bf16_t* V; const float* ssqc; const float* ssqkr; const float* KR; const float* gk; const float* cs; const float* sn; LAS float* xch;
    __device__ __forceinline__ void operator()(AccT acc, const pg8::Unit& u, int wr, int wc, int fr, int fq) const {
        const int cw = wc * 32 + fq * 8;
        float rc[2][4];
#pragma unroll
        for (int ai = 0; ai < 2; ++ai)
#pragma unroll
            for (int m = 0; m < 4; ++m) { const int rt = ai * 128 + wr * 64 + m * 16 + fr, row = u.pm * 256 + rt;
                rc[ai][m] = 1.0f / sqrtf(ssqc[row] * (1.0f / KVL) + EPS);
                const f32x4 v0 = acc[ai][0][m][0], v1 = acc[ai][0][m][1];
                float s = (v0[0] * v0[0] + v0[1] * v0[1]) + (v0[2] * v0[2] + v0[3] * v0[3]) + (v1[0] * v1[0] + v1[1] * v1[1]) + (v1[2] * v1[2] + v1[3] * v1[3]);
                s = sum_fq(s);
                if (fq == 0) xch[rt * 4 + wc] = s * rc[ai][m] * rc[ai][m]; }
        asm volatile("s_waitcnt lgkmcnt(0)" ::: "memory"); __builtin_amdgcn_s_barrier(); asm volatile("" ::: "memory");
        const f32x4 g0 = *(const f32x4*)(gk + cw), g1 = *(const f32x4*)(gk + cw + 4);
        const int i0 = (wc * 4 + fq) * 2;
        const float ga0 = gk[128 + i0], ga1 = gk[129 + i0], gb0 = gk[160 + i0], gb1 = gk[161 + i0];
#pragma unroll
        for (int ai = 0; ai < 2; ++ai)
#pragma unroll
            for (int m = 0; m < 4; ++m) { const int rt = ai * 128 + wr * 64 + m * 16 + fr, row = u.pm * 256 + rt;
                const f32x4 pp = *(const LAS f32x4*)(xch + rt * 4);
                const float rk = 1.0f / sqrtf(((pp[0] + pp[1]) + (pp[2] + pp[3]) + ssqkr[row]) * (1.0f / QKH) + EPS), rcv = rc[ai][m], rn = rcv * rk;
                const size_t R = (size_t)((row >> 12) * NH + u.pn) * SEQ + (row & (SEQ - 1));
                *(u32x4*)(K + R * QKH + cw) = pack8(acc[ai][0][m][0] * rn * g0, acc[ai][0][m][1] * rn * g1);
                *(u32x4*)(V + R * VH + cw) = pack8(acc[ai][1][m][0] * rcv, acc[ai][1][m][1] * rcv);
                const float a0 = KR[(size_t)row * 64 + i0] * rk * ga0, a1 = KR[(size_t)row * 64 + i0 + 1] * rk * ga1, b0 = KR[(size_t)row * 64 + 32 + i0] * rk * gb0, b1 = KR[(size_t)row * 64 + 33 + i0] * rk * gb1;
                const float c0 = cs[(size_t)row * 32 + i0], c1 = cs[(size_t)row * 32 + i0 + 1], s0 = sn[(size_t)row * 32 + i0], s1 = sn[(size_t)row * 32 + i0 + 1];
                *(unsigned*)(K + R * QKH + 128 + i0) = pk2(a0 * c0 - b0 * s0, a1 * c1 - b1 * s1);
                *(unsigned*)(K + R * QKH + 160 + i0) = pk2(b0 * c0 + a0 * s0, b1 * c1 + a1 * s1); }
    }
};
struct EpiQb {
    static constexpr bool PERM = true, AFTER_DRAIN = false, ALIGN = true;
    bf16_t* Q; const float* ssqq;
    __device__ __forceinline__ void operator()(AccT acc, const pg8::Unit& u, int wr, int wc, int fr, int fq) const {
        const int col0 = u.pn * 256 + wc * 32 + fq * 8;
        EPI_ROWS(
            const float rinv = 1.0f / sqrtf(ssqq[row] * (1.0f / QL_) + EPS);
            _Pragma("unroll") for (int bj = 0; bj < 2; ++bj) { const int col = col0 + bj * 128, head = col / QKH, d = col - head * QKH;
                const size_t R = (size_t)((row >> 12) * NH + head) * SEQ + (row & (SEQ - 1));
                *(u32x4*)(Q + R * QKH + d) = pack8(acc[ai][bj][m][0] * rinv, acc[ai][bj][m][1] * rinv); }
        )
    }
};
#define RLX_AGENT __ATOMIC_RELAXED, __HIP_MEMORY_SCOPE_AGENT
#define XB_TMO      128
#define XB_XCNT(j)  (256  + 64 * (j))
#define XB_XSUB(j)  (1280 + 64 * (j))
#define XB_XGEN(j)  (2304 + 64 * (j))
#define XB_TOP      3328
#define XB_TOPGEN   3392
#define XCD_BAR_WORDS 3456
#define XB_SPIN_CAP (1u << 18)

__device__ __forceinline__ unsigned xb_ld(unsigned* p)              { return __hip_atomic_load(p, __ATOMIC_RELAXED, __HIP_MEMORY_SCOPE_AGENT); }
__device__ __forceinline__ unsigned xb_add(unsigned* p, unsigned v) { return __hip_atomic_fetch_add(p, v, __ATOMIC_RELAXED, __HIP_MEMORY_SCOPE_AGENT); }
__device__ __forceinline__ unsigned xb_xcc_id() { return (unsigned)__builtin_amdgcn_s_getreg((3 << 11) | 20) & 0xFu; }
#define XB_SPIN(cond, bar) do { unsigned _sp = 0; while (cond) { __builtin_amdgcn_s_sleep(1); \
    if ((++_sp & 255u) == 0u) { if (xb_ld(&(bar)[XB_TMO])) break; if (_sp > XB_SPIN_CAP) { atomicAdd(&(bar)[XB_TMO], 1u); break; } } } } while (0)

struct XcdBarrier {
    unsigned* bar; unsigned x;
    volatile LAS unsigned* st;
};

__device__ __forceinline__ XcdBarrier xcd_barrier_post(unsigned* bar, volatile LAS unsigned* st) {
    XcdBarrier b; b.bar = bar; b.x = xb_xcc_id(); b.st = st;
    if (threadIdx.x == 0) (void)xb_add(&bar[XB_XCNT(b.x)], 1u);
    return b;
}
__device__ __forceinline__ void xcd_barrier_complete(unsigned* bar, unsigned x, unsigned& nloc, unsigned& nx) {
    const unsigned G = gridDim.x * gridDim.y * gridDim.z;
    unsigned sum, cnt, mine, sp = 0u;
    for (;;) {
        sum = 0u; cnt = 0u; mine = 0u;
#pragma unroll
        for (unsigned j = 0; j < 16; ++j) { const unsigned c = xb_ld(&bar[XB_XCNT(j)]); sum += c; cnt += (c > 0u) ? 1u : 0u; mine = (j == x) ? c : mine; }
        if (sum == G) break;
        __builtin_amdgcn_s_sleep(1);
        if ((++sp & 255u) == 0u) { if (xb_ld(&bar[XB_TMO])) break; if (sp > XB_SPIN_CAP) { atomicAdd(&bar[XB_TMO], 1u); break; } }
    }
    nloc = mine > 0u ? mine : 1u; nx = cnt > 0u ? cnt : 1u;
}

__device__ __forceinline__ void xcd_barrier(const XcdBarrier& b) {
    asm volatile("s_waitcnt vmcnt(0)" ::: "memory");
    __syncthreads();
    if (threadIdx.x == 0) {
        unsigned* bar = b.bar;
        __builtin_amdgcn_s_waitcnt(0);
        unsigned nloc = b.st[0], nx = b.st[1];
        if (nloc == 0u) { xcd_barrier_complete(bar, b.x, nloc, nx); b.st[0] = nloc; b.st[1] = nx; }
        const unsigned old = xb_add(&bar[XB_XSUB(b.x)], 1u);
        const unsigned gen = old / nloc;
        if (old + 1u == (gen + 1u) * nloc) {
            __builtin_amdgcn_fence(__ATOMIC_RELEASE, "agent");
            asm volatile("s_waitcnt vmcnt(0)" ::: "memory");
            const unsigned og = xb_add(&bar[XB_TOP], 1u);
            const unsigned tg = og / nx;
            if (og + 1u == (tg + 1u) * nx) xb_add(&bar[XB_TOPGEN], 1u);
            else XB_SPIN(xb_ld(&bar[XB_TOPGEN]) == tg, bar);
            __builtin_amdgcn_fence(__ATOMIC_ACQUIRE, "agent");
            xb_add(&bar[XB_XGEN(b.x)], 1u);
            asm volatile("s_waitcnt vmcnt(0)" ::: "memory");
        } else {
            XB_SPIN(xb_ld(&bar[XB_XGEN(b.x)]) == gen, bar);
            __builtin_amdgcn_fence(__ATOMIC_ACQUIRE, "agent");
            asm volatile("s_waitcnt vmcnt(0)" ::: "memory");
        }
    }
    __syncthreads();
}
namespace att {
using f32x16 = __attribute__((ext_vector_type(16))) float;
using s16x4  = __attribute__((ext_vector_type(4))) short;
constexpr int NW = 8, QBLK = 32, KVBLK = 64;
constexpr float SCALE = 0.07216878364870322f;
constexpr float THR = 8.f;
constexpr int SHM_V = KVBLK * VH * 2, SHM_K = KVBLK * QKH * 2;
constexpr int NSLOT = 3;
constexpr int LDS_KR = 0, LDS_VR = NSLOT * SHM_K, LDS_WSF = LDS_VR + NSLOT * SHM_V, SHM_ATTN = LDS_WSF + NW * 64 * 4;
#define KSWZ(row, ch) ((row) * 384 + ((((ch) ^ (((row) >> 1) & 7))) << 4))
#define SBAR() __builtin_amdgcn_sched_barrier(0)
__device__ __forceinline__ int crow(int r, int hi) { return (r & 3) + 8 * (r >> 2) + 4 * hi; }
__device__ __forceinline__ unsigned cvtpk(float lo, float hi) { unsigned r; asm volatile("v_cvt_pk_bf16_f32 %0, %1, %2" : "=v"(r) : "v"(lo), "v"(hi)); return r; }

__device__ __forceinline__ void partialSM(f32x16& p0, f32x16& p1, float& m_reg, float& mn, float& alpha, bool visible) {
  constexpr float C = SCALE * 1.4426950408889634f;
  if (__builtin_expect(!visible, 0)) { for (int r = 0; r < 16; ++r) { p0[r] = -1e30f; p1[r] = -1e30f; } asm volatile("" : "+v"(p0), "+v"(p1)); }
  float pmax = p0[0]; for (int r = 1; r < 16; ++r) pmax = fmaxf(pmax, p0[r]); for (int r = 0; r < 16; ++r) pmax = fmaxf(pmax, p1[r]);
  { auto rr = __builtin_amdgcn_permlane32_swap(__float_as_uint(pmax), __float_as_uint(pmax), false, false);
    pmax = fmaxf(__uint_as_float(rr[0]), __uint_as_float(rr[1])); }
  if (__builtin_expect(__all(pmax - m_reg <= THR / SCALE), 1)) { mn = m_reg; alpha = 1.f; }
  else { mn = fmaxf(m_reg, pmax); alpha = __builtin_amdgcn_exp2f((m_reg - mn) * C); m_reg = mn; }
  float mnC = -mn * C;
  for (int r = 0; r < 16; ++r) p0[r] = fmaf(p0[r], C, mnC); for (int r = 0; r < 16; ++r) p1[r] = fmaf(p1[r], C, mnC);
  for (int r = 0; r < 16; ++r) p0[r] = __builtin_amdgcn_exp2f(p0[r]);
}
__device__ __forceinline__ void finishSM(f32x16& p0, f32x16& p1, float alpha, float& l_reg, bf16x8& pa0, bf16x8& pa1, bf16x8& pa2, bf16x8& pa3) {
  for (int r = 0; r < 16; ++r) p1[r] = __builtin_amdgcn_exp2f(p1[r]);
  float ps = 0; for (int r = 0; r < 16; ++r) ps += p0[r]; for (int r = 0; r < 16; ++r) ps += p1[r];
  { auto rr = __builtin_amdgcn_permlane32_swap(__float_as_uint(ps), __float_as_uint(ps), false, false);
    ps = __uint_as_float(rr[0]) + __uint_as_float(rr[1]); }
  l_reg = l_reg * alpha + ps;
#define PK4(P, BASE, OUT) do { unsigned a0 = cvtpk(P[BASE + 0], P[BASE + 1]), a1 = cvtpk(P[BASE + 2], P[BASE + 3]);   \
    unsigned b0 = cvtpk(P[BASE + 4], P[BASE + 5]), b1 = cvtpk(P[BASE + 6], P[BASE + 7]);                              \
    auto r0 = __builtin_amdgcn_permlane32_swap(a0, b0, false, false); auto r1 = __builtin_amdgcn_permlane32_swap(a1, b1, false, false); \
    u32x4 w = {r0[0], r1[0], r0[1], r1[1]}; OUT = *reinterpret_cast<bf16x8*>(&w); } while (0)
  PK4(p0, 0, pa0); PK4(p0, 8, pa1); PK4(p1, 0, pa2); PK4(p1, 8, pa3);
#undef PK4
}
__device__ __forceinline__ void qkt(f32x16& p0, f32x16& p1, const int (&ka)[4], int slot_off, const bf16x8* qr) {
  constexpr int PD = 2;
  bf16x8 kf0[12], kf1[12]; int kb[4];
#pragma unroll
  for (int jj = 0; jj < 4; ++jj) kb[jj] = ka[jj] + slot_off;
  p0 = f32x16{}; p1 = f32x16{};
#define QK_ISSUE(s) do { \
    asm volatile("ds_read_b128 %0, %1 offset:%c2" : "=v"(kf0[s]) : "v"(kb[(s) & 3]), "i"(((s) >> 2) * 128) : "memory"); \
    asm volatile("ds_read_b128 %0, %1 offset:%c2" : "=v"(kf1[s]) : "v"(kb[(s) & 3]), "i"(((s) >> 2) * 128 + 12288) : "memory"); } while (0)
#pragma unroll
  for (int s = 0; s < PD; ++s) QK_ISSUE(s);
#pragma unroll
  for (int d0 = 0; d0 < 12; ++d0) {
    if (d0 + PD < 12) QK_ISSUE(d0 + PD);
    const int later = 2 * ((d0 + PD < 12 ? d0 + PD : 11) - d0);
    asm volatile("s_waitcnt lgkmcnt(%c2)" : "+v"(kf0[d0]), "+v"(kf1[d0]) : "i"(later));
    p0 = __builtin_amdgcn_mfma_f32_32x32x16_bf16(kf0[d0], qr[d0], p0, 0, 0, 0);
    p1 = __builtin_amdgcn_mfma_f32_32x32x16_bf16(kf1[d0], qr[d0], p1, 0, 0, 0);
  }
#undef QK_ISSUE
}
__device__ __forceinline__ void glds16(const void* gsrc, unsigned lds_dst) { unsigned keep;
  asm volatile("s_mov_b32 %0, m0\n\ts_mov_b32 m0, %2\n\ts_nop 0\n\tglobal_load_lds_dwordx4 %1, off\n\ts_mov_b32 m0, %0" : "=&s"(keep) : "v"(gsrc), "s"(lds_dst) : "memory"); }
__device__ __forceinline__ int v_st(int k, int c) { const int kk = (k & ~0xC) | ((k & 4) << 1) | ((k & 8) >> 1); return ((kk >> 3) * 4 + (c >> 5)) * 512 + ((kk & 7) * 32 + (c & 31)) * 2; }
__device__ __forceinline__ int v_rd_base(int lane) { return ((lane & 3) << 3) | (((lane >> 2) & 3) << 6) | (((lane >> 4) & 1) << 5) | (((lane >> 5) & 1) << 8); }
constexpr int v_rd_off(int d0, int ks, int half) { return d0 * 512 + ks * 4096 + half * 2048; }
template <int OFF> __device__ __forceinline__ s16x4 tr_read(int vb) {
  s16x4 r; asm volatile("ds_read_b64_tr_b16 %0, %1 offset:%2" : "=&v"(r) : "v"(vb), "i"(OFF) : "memory"); return r;
}
template <int KS> __device__ __forceinline__ void pv_ks(f32x16* o, int vb, bf16x8 pa) {
  const s16x4 l0 = tr_read<v_rd_off(0, KS, 0)>(vb), h0 = tr_read<v_rd_off(0, KS, 1)>(vb), l1 = tr_read<v_rd_off(1, KS, 0)>(vb), h1 = tr_read<v_rd_off(1, KS, 1)>(vb);
  const s16x4 l2 = tr_read<v_rd_off(2, KS, 0)>(vb), h2 = tr_read<v_rd_off(2, KS, 1)>(vb), l3 = tr_read<v_rd_off(3, KS, 0)>(vb), h3 = tr_read<v_rd_off(3, KS, 1)>(vb);
  asm volatile("s_waitcnt lgkmcnt(0)" ::: "memory"); SBAR();
#define PK(L, H) (bf16x8){L[0], L[1], L[2], L[3], H[0], H[1], H[2], H[3]}
  o[0] = __builtin_amdgcn_mfma_f32_32x32x16_bf16(pa, PK(l0, h0), o[0], 0, 0, 0);
  o[1] = __builtin_amdgcn_mfma_f32_32x32x16_bf16(pa, PK(l1, h1), o[1], 0, 0, 0);
  o[2] = __builtin_amdgcn_mfma_f32_32x32x16_bf16(pa, PK(l2, h2), o[2], 0, 0, 0);
  o[3] = __builtin_amdgcn_mfma_f32_32x32x16_bf16(pa, PK(l3, h3), o[3], 0, 0, 0);
#undef PK
}
__device__ __forceinline__ void pv_d0(f32x16* o, int vb, bf16x8 pa0, bf16x8 pa1, bf16x8 pa2, bf16x8 pa3) {
  pv_ks<0>(o, vb, pa0); pv_ks<1>(o, vb, pa1); pv_ks<2>(o, vb, pa2); pv_ks<3>(o, vb, pa3);
}

__device__ __forceinline__ void attn_unit(const bf16_t* __restrict__ Qh, const bf16_t* __restrict__ Kh, const bf16_t* __restrict__ Vh,
                                          const bf16_t* Gt, bf16_t* Ot  , int qb, char* lds,
                                          const float* __restrict__ gq, const float* __restrict__ cs_b, const float* __restrict__ sn_b) {
  int tid_l = threadIdx.x; asm volatile("" : "+v"(tid_l));
  const int tid = tid_l, wid = __builtin_amdgcn_readfirstlane(tid >> 6), lane = tid & 63, r32 = lane & 31, hi = lane >> 5;
  const unsigned lds0 = (unsigned)(uintptr_t)lds;
  float* ws = (float*)(lds + LDS_WSF) + wid * 64; float* li_l = ws; float* al_l = ws + 32;
  float m_reg = -1e30f, l_reg = 0; f32x16 o[4] = {}; bf16x8 qr[12];
  const int q0 = qb * 256;
  const bf16_t* Qw = Qh + (size_t)(q0 + wid * QBLK + r32) * QKH + hi * 8;
  int gko[3], gvo[2];
#pragma unroll
  for (int i = 0; i < 3; ++i) { const int q = (i * 8 + wid) * 64 + lane, row = q / 24, chs = q - row * 24, ch = chs ^ ((row >> 1) & 7); gko[i] = row * QKH + ch * 8; }
#pragma unroll
  for (int i = 0; i < 2; ++i) { const int q = (i * 8 + wid) * 64 + lane, st = q >> 5, kk = (st >> 2) * 8 + ((q & 31) >> 2), cc = (st & 3) * 32 + (q & 3) * 8;
    const int k = (kk & ~0xC) | ((kk & 4) << 1) | ((kk & 8) >> 1); gvo[i] = k * VH + cc; }
#define DMA_K(t, slot) do { _Pragma("unroll") for (int i_ = 0; i_ < 3; ++i_) glds16(Kh + (size_t)(t) * (KVBLK * QKH) + gko[i_], (unsigned)__builtin_amdgcn_readfirstlane(lds0 + LDS_KR + (slot) * SHM_K + (i_ * 8 + wid) * 1024)); } while (0)
#define DMA_V(t, slot) do { _Pragma("unroll") for (int i_ = 0; i_ < 2; ++i_) glds16(Vh + (size_t)(t) * (KVBLK * VH) + gvo[i_], (unsigned)__builtin_amdgcn_readfirstlane(lds0 + LDS_VR + (slot) * SHM_V + (i_ * 8 + wid) * 1024)); } while (0)
#define WAITBAR(N) asm volatile("s_waitcnt vmcnt(" #N ") lgkmcnt(0)\n\ts_barrier" ::: "memory")
  DMA_K(0, 0); DMA_V(0, 0); DMA_K(1, 1);
  {
    float xq[12][8]; float ss = 0.f;
#pragma unroll
    for (int d0 = 0; d0 < 12; ++d0) { const u32x4 w = __builtin_nontemporal_load(reinterpret_cast<const u32x4*>(Qw + d0 * 16));
      xq[d0][0] = bflo(w.x); xq[d0][1] = bfhi(w.x); xq[d0][2] = bflo(w.y); xq[d0][3] = bfhi(w.y); xq[d0][4] = bflo(w.z); xq[d0][5] = bfhi(w.z); xq[d0][6] = bflo(w.w); xq[d0][7] = bfhi(w.w);
#pragma unroll
      for (int k = 0; k < 8; ++k) ss += xq[d0][k] * xq[d0][k]; }
    { auto rr = __builtin_amdgcn_permlane32_swap(__float_as_uint(ss), __float_as_uint(ss), false, false); ss = __uint_as_float(rr[0]) + __uint_as_float(rr[1]); }
    const float rinv = 1.0f / sqrtf(ss * (1.0f / QKH) + EPS);
#pragma unroll
    for (int d0 = 0; d0 < 12; ++d0) { const f32x4 g0 = *(const f32x4*)(gq + d0 * 16 + hi * 8), g1 = *(const f32x4*)(gq + d0 * 16 + hi * 8 + 4);
#pragma unroll
      for (int k = 0; k < 4; ++k) { xq[d0][k] *= rinv * g0[k]; xq[d0][4 + k] *= rinv * g1[k]; } }
    const size_t trow = (size_t)(q0 + wid * QBLK + r32) * 32 + hi * 8;
#pragma unroll
    for (int p = 0; p < 2; ++p) { const f32x4 c0 = *(const f32x4*)(cs_b + trow + p * 16), c1 = *(const f32x4*)(cs_b + trow + p * 16 + 4), s0 = *(const f32x4*)(sn_b + trow + p * 16), s1 = *(const f32x4*)(sn_b + trow + p * 16 + 4);
#pragma unroll
      for (int k = 0; k < 8; ++k) { const float cc = k < 4 ? c0[k & 3] : c1[k & 3], sv = k < 4 ? s0[k & 3] : s1[k & 3]; const float a = xq[8 + p][k], b = xq[10 + p][k];
        xq[8 + p][k] = a * cc - b * sv; xq[10 + p][k] = b * cc + a * sv; } }
#pragma unroll
    for (int d0 = 0; d0 < 12; ++d0) { u32x4 w; w.x = cvtpk(xq[d0][0], xq[d0][1]); w.y = cvtpk(xq[d0][2], xq[d0][3]); w.z = cvtpk(xq[d0][4], xq[d0][5]); w.w = cvtpk(xq[d0][6], xq[d0][7]);
      qr[d0] = __builtin_bit_cast(bf16x8, w); }
  }
  int ka[4];
#pragma unroll
  for (int jj = 0; jj < 4; ++jj) ka[jj] = (int)(lds0 + LDS_KR) + r32 * 384 + (((2 * jj + hi) ^ ((r32 >> 1) & 7)) << 4);
  const int jmax = (q0 + wid * QBLK) >> 6;
  const int vb0 = (int)(lds0 + LDS_VR) + v_rd_base(lane);
#define RESC(a) do { if (__any((a) < 1.f)) { if (hi == 0) al_l[r32] = (a); asm volatile("s_waitcnt lgkmcnt(0)" ::: "memory"); \
    for (int d = 0; d < 4; ++d) for (int r = 0; r < 16; ++r) o[d][r] *= al_l[crow(r, hi)]; } } while (0)
  f32x16 pA0, pA1, pB0, pB1; float mnA, mnB, alA, alB; bf16x8 pa0, pa1, pa2, pa3; const int NT = (q0 + 256) / KVBLK;
  int s0 = 0, s1 = 1, s2 = 2;
#define ROT() do { const int t_ = s0; s0 = s1; s1 = s2; s2 = t_; } while (0)
  WAITBAR(0);
  DMA_K(2, s2); DMA_V(1, s1);
  qkt(pA0, pA1, ka, s0 * SHM_K, qr); partialSM(pA0, pA1, m_reg, mnA, alA, true);
  WAITBAR(5); ROT();
  for (int j = 1; j + 1 < NT; j += 2) {
    DMA_K(j + 2, s2); DMA_V(j + 1, s1);
    if (j <= jmax) { SBAR(); qkt(pB0, pB1, ka, s0 * SHM_K, qr); }
    if (j - 1 <= jmax) { finishSM(pA0, pA1, alA, l_reg, pa0, pa1, pa2, pa3); SBAR();
      pv_d0(o, vb0 + s2 * SHM_V, pa0, pa1, pa2, pa3); }
    if (j <= jmax) { partialSM(pB0, pB1, m_reg, mnB, alB, true); RESC(alB); }
    WAITBAR(5); ROT();
    const bool more = j + 3 < NT;
    if (more) DMA_K(j + 3, s2);
    DMA_V(j + 2, s1);
    if (j + 1 <= jmax) { SBAR(); qkt(pA0, pA1, ka, s0 * SHM_K, qr); }
    if (j <= jmax) { finishSM(pB0, pB1, alB, l_reg, pa0, pa1, pa2, pa3); SBAR();
      pv_d0(o, vb0 + s2 * SHM_V, pa0, pa1, pa2, pa3); }
    if (j + 1 <= jmax) { partialSM(pA0, pA1, m_reg, mnA, alA, true); RESC(alA); }
    if (more) WAITBAR(5); else WAITBAR(2);
    ROT();
  }
  if (NT - 1 <= jmax) { SBAR(); qkt(pB0, pB1, ka, s0 * SHM_K, qr); }
  if (NT - 2 <= jmax) { finishSM(pA0, pA1, alA, l_reg, pa0, pa1, pa2, pa3); SBAR();
    pv_d0(o, vb0 + s2 * SHM_V, pa0, pa1, pa2, pa3); }
  if (NT - 1 <= jmax) { partialSM(pB0, pB1, m_reg, mnB, alB, true); RESC(alB); }
  WAITBAR(0);
  if (NT - 1 <= jmax) { finishSM(pB0, pB1, alB, l_reg, pa0, pa1, pa2, pa3); SBAR();
    pv_d0(o, vb0 + s0 * SHM_V, pa0, pa1, pa2, pa3); }
  if (hi == 0) li_l[r32] = l_reg; asm volatile("s_waitcnt lgkmcnt(0)" ::: "memory");
  float rli[16];
#pragma unroll
  for (int r = 0; r < 16; ++r) rli[r] = __builtin_amdgcn_rcpf(li_l[crow(r, hi)]);
  const size_t rowb = (size_t)(q0 + wid * QBLK);
  float* stg = (float*)(lds + LDS_KR + wid * 8192);
#pragma unroll
  for (int hh = 0; hh < 2; ++hh) {
#pragma unroll
    for (int r = 0; r < 16; ++r) { const int orow = crow(r, hi);
      stg[orow * 64 + r32] = o[2 * hh][r] * rli[r]; stg[orow * 64 + 32 + r32] = o[2 * hh + 1][r] * rli[r]; }
#pragma unroll
    for (int i = 0; i < 4; ++i) { const int row = i * 8 + (lane >> 3), ch = lane & 7;
      const f32x4 a = *(const f32x4*)(stg + row * 64 + ch * 8), b = *(const f32x4*)(stg + row * 64 + ch * 8 + 4);
      const size_t off = (rowb + row) * WB + hh * 64 + ch * 8;
      const u32x4 g = __builtin_nontemporal_load((const u32x4*)(Gt + off));
      u32x4 w; w.x = cvtpk(a[0] * bflo(g.x), a[1] * bfhi(g.x)); w.y = cvtpk(a[2] * bflo(g.y), a[3] * bfhi(g.y)); w.z = cvtpk(b[0] * bflo(g.z), b[1] * bfhi(g.z)); w.w = cvtpk(b[2] * bflo(g.w), b[3] * bfhi(g.w));
      *(u32x4*)(Ot + off) = w; }
  }
  asm volatile("s_waitcnt lgkmcnt(0)\n\ts_barrier" ::: "memory");
#undef DMA_K
#undef DMA_V
#undef WAITBAR
#undef RESC
#undef ROT
}
#undef SBAR
}
struct Ctx { int tid, lane, wave, gw, ngw; LAS unsigned char* lds; };

__device__ __forceinline__ void transpose_item(const float* __restrict__ W, int K, int N, int ldw, bf16_t* __restrict__ WT, int row_off, const float* __restrict__ gain, LAS float* scr, int item, int lane) {
    const int nblk = N / 32, kb = item / nblk, nb = item % nblk, k0 = 64 * kb, n0 = 32 * nb;
    float wv[32];
    const float* wp = W + (size_t)(k0 + (lane >> 5)) * ldw + n0 + (lane & 31);
#pragma unroll
    for (int i = 0; i < 32; ++i) wv[i] = __builtin_nontemporal_load(wp + (size_t)(2 * i) * ldw);
    if (gain) {
#pragma unroll
        for (int i = 0; i < 32; ++i) wv[i] *= gain[k0 + 2 * i + (lane >> 5)];
    }
#pragma unroll
    for (int i = 0; i < 32; ++i) scr[(2 * i + (lane >> 5)) * 33 + (lane & 31)] = wv[i];
    asm volatile("s_waitcnt lgkmcnt(0)" ::: "memory");
    const int c = lane & 7;
#pragma unroll
    for (int j = 0; j < 4; ++j) { const int n = (lane >> 3) + 8 * j; const LAS float* s = scr + (8 * c) * 33 + n;
        u32x4 o; o.x = pk2(s[0 * 33], s[1 * 33]); o.y = pk2(s[2 * 33], s[3 * 33]); o.z = pk2(s[4 * 33], s[5 * 33]); o.w = pk2(s[6 * 33], s[7 * 33]);
        *(u32x4*)(WT + (size_t)(row_off + n0 + n) * K + k0 + 8 * c) = o; }
    asm volatile("s_waitcnt lgkmcnt(0)" ::: "memory");
}
__device__ __forceinline__ void convert_weight(const Ctx& c, const float* W, int K, int N, bf16_t* WT, int row_off, const float* gain, int ldw = 0) {
    LAS float* scr = (LAS float*)(c.lds + c.wave * 16384);
    const int nitems = (K / 64) * (N / 32);
    for (int it = c.gw; it < nitems; it += c.ngw) transpose_item(W, K, N, ldw ? ldw : N, WT, row_off, gain, scr, it, c.lane);
}
__device__ __forceinline__ void convert_plain(const Ctx& c, const float* __restrict__ W, int K, int ncols, int ldw, bf16_t* __restrict__ out, int ldo, int coff, const float* __restrict__ gain) {
    const int per_row = ncols / 8, total = K * per_row, stride = c.ngw * 64;
    for (int i0 = c.gw * 64 + c.lane; i0 < total; i0 += 4 * stride) {
        f32x4 a[4], b[4]; int kk[4], cc[4];
#pragma unroll
        for (int u = 0; u < 4; ++u) { const int i = i0 + u * stride; const bool ok = i < total; const int ii = ok ? i : i0; kk[u] = ii / per_row; cc[u] = (ii - kk[u] * per_row) * 8;
            a[u] = __builtin_nontemporal_load((const f32x4*)(W + (size_t)kk[u] * ldw + cc[u])); b[u] = __builtin_nontemporal_load((const f32x4*)(W + (size_t)kk[u] * ldw + cc[u] + 4)); }
#pragma unroll
        for (int u = 0; u < 4; ++u) { if (i0 + u * stride < total) { const float g = gain[kk[u]]; *(u32x4*)(out + (size_t)kk[u] * ldo + coff + cc[u]) = pack8(a[u] * g, b[u] * g); } }
    }
}
__device__ __forceinline__ void xprep_rows(const Ctx& c, const float* __restrict__ x, bf16_t* __restrict__ xb, float* __restrict__ ssq) {
    for (int r = c.gw; r < MTOK; r += c.ngw) {
        const f32x4* xr = (const f32x4*)(x + (size_t)r * DM) + c.lane;
        f32x4 v[8]; float s = 0.f;
#pragma unroll
        for (int j = 0; j < 8; ++j) { v[j] = __builtin_nontemporal_load(xr + 64 * j); s += (v[j].x * v[j].x + v[j].y * v[j].y) + (v[j].z * v[j].z + v[j].w * v[j].w); }
        s = wave_sum(s);
        if (c.lane == 0) ssq[r] = s;
        u32x2* o = (u32x2*)(xb + (size_t)r * DM) + c.lane;
#pragma unroll
        for (int j = 0; j < 8; ++j) { u32x2 w; w.x = pk2(v[j].x, v[j].y); w.y = pk2(v[j].z, v[j].w); o[64 * j] = w; }
    }
}
__device__ __forceinline__ void rope_tables(const Ctx& c, const int* __restrict__ pos, float* __restrict__ cs, float* __restrict__ sn) {
    const int gt = c.gw * 64 + c.lane, ngt = c.ngw * 64;
    for (int i = gt; i < MTOK * 32; i += ngt) {
        const int t = i >> 5, f = i & 31;
        const float inv = exp2f(-(float)f * 0.41524101186092029f);
        const float ang = (float)pos[t] * inv;
        float sd, cd; sincosf(ang, &sd, &cd);
        cs[i] = cd; sn[i] = sd;
    }
}
__device__ __forceinline__ void load8(const bf16_t* p, float* f) { const u32x4 w = __builtin_nontemporal_load((const u32x4*)p); f[0] = bflo(w.x); f[1] = bfhi(w.x); f[2] = bflo(w.y); f[3] = bfhi(w.y); f[4] = bflo(w.z); f[5] = bfhi(w.z); f[6] = bflo(w.w); f[7] = bfhi(w.w); }
__device__ __forceinline__ void pool_phase(const Ctx& c, const bf16_t* __restrict__ U, bf16_t* __restrict__ P, const bf16_t* __restrict__ G, const float* __restrict__ scale) {
    constexpr int SEGL = 64, NSEG = MTOK / SEGL;
    for (int seg = blockIdx.x; seg < NSEG; seg += gridDim.x) {
        const int t0 = seg * SEGL, s0 = t0 & (SEQ - 1), col = c.tid * 8, w = 2 << (col >> 10);
        const bf16_t* Uc = U + col; bf16_t* Pc = P + col; const bf16_t* Gc = G + col;
        float sc[8];
#pragma unroll
        for (int k = 0; k < 8; ++k) sc[k] = scale[col + k];
        float sum[8];
#pragma unroll
        for (int k = 0; k < 8; ++k) sum[k] = 0.f;
        for (int i = 1; i <= w; ++i) { if (s0 - i >= 0) { float f[8]; load8(Uc + (size_t)(t0 - i) * WA, f);
#pragma unroll
            for (int k = 0; k < 8; ++k) sum[k] += f[k]; } }
        const float rw = 1.0f / (float)w;
#pragma unroll 4
        for (int i = 0; i < SEGL; ++i) {
            const int t = t0 + i, s = s0 + i; float f[8], old[8];
            load8(Uc + (size_t)t * WA, f);
            if (s >= w) load8(Uc + (size_t)(t - w) * WA, old); else {
#pragma unroll
                for (int k = 0; k < 8; ++k) old[k] = 0.f; }
            const float rc = (s + 1 < w) ? 1.0f / (float)(s + 1) : rw;
            float o[8], gt[8]; load8(Gc + (size_t)t * WA, gt);
#pragma unroll
            for (int k = 0; k < 8; ++k) { sum[k] += f[k] - old[k]; o[k] = (sum[k] * rc - f[k]) * sc[k] * gt[k]; }
            u32x4 pw; pw.x = pk2(o[0], o[1]); pw.y = pk2(o[2], o[3]); pw.z = pk2(o[4], o[5]); pw.w = pk2(o[6], o[7]);
            *(u32x4*)(Pc + (size_t)t * WA) = pw;
        }
    }
}
template <bool ISK>
__device__ __forceinline__ void qknorm_rope(const Ctx& c, bf16_t* __restrict__ T, const float* __restrict__ KR, const float* __restrict__ g, const float* __restrict__ cs, const float* __restrict__ sn) {
    const int l = c.lane & 7, sub = c.lane >> 3;
    float gn[16], g1[4], g2[4];
#pragma unroll
    for (int k = 0; k < 16; ++k) gn[k] = g[16 * l + k];
#pragma unroll
    for (int k = 0; k < 4; ++k) { g1[k] = g[128 + 4 * l + k]; g2[k] = g[160 + 4 * l + k]; }
    const int nvec = MTOK * NH;
    for (int v = c.gw * 8 + sub; v < nvec; v += c.ngw * 8) {
        const int s = v & (SEQ - 1), bh = v >> 12, tok = (bh >> 4) * SEQ + s;
        bf16_t* p = T + (size_t)v * QKH;
        float x[16], t1[4], t2[4];
        load8(p + 16 * l, x); load8(p + 16 * l + 8, x + 8);
        if (ISK) { const f32x4 a = *(const f32x4*)(KR + (size_t)tok * 64 + 4 * l), b = *(const f32x4*)(KR + (size_t)tok * 64 + 32 + 4 * l);
#pragma unroll
            for (int k = 0; k < 4; ++k) { t1[k] = a[k]; t2[k] = b[k]; } }
        else { const u32x2 a = *(const u32x2*)(p + 128 + 4 * l), b = *(const u32x2*)(p + 160 + 4 * l);
            t1[0] = bflo(a.x); t1[1] = bfhi(a.x); t1[2] = bflo(a.y); t1[3] = bfhi(a.y); t2[0] = bflo(b.x); t2[1] = bfhi(b.x); t2[2] = bflo(b.y); t2[3] = bfhi(b.y); }
        float ss = 0.f;
#pragma unroll
        for (int k = 0; k < 16; ++k) ss += x[k] * x[k];
#pragma unroll
        for (int k = 0; k < 4; ++k) ss += t1[k] * t1[k] + t2[k] * t2[k];
        ss += __shfl_xor(ss, 1); ss += __shfl_xor(ss, 2); ss += __shfl_xor(ss, 4);
        const float rinv = 1.0f / sqrtf(ss * (1.0f / QKH) + EPS);
        const f32x4 cc = *(const f32x4*)(cs + (size_t)tok * 32 + 4 * l), sv = *(const f32x4*)(sn + (size_t)tok * 32 + 4 * l);
        u32x4 w0, w1;
#pragma unroll
        for (int k = 0; k < 16; ++k) x[k] *= rinv * gn[k];
        w0.x = pk2(x[0], x[1]); w0.y = pk2(x[2], x[3]); w0.z = pk2(x[4], x[5]); w0.w = pk2(x[6], x[7]);
        w1.x = pk2(x[8], x[9]); w1.y = pk2(x[10], x[11]); w1.z = pk2(x[12], x[13]); w1.w = pk2(x[14], x[15]);
        float o1[4], o2[4];
#pragma unroll
        for (int k = 0; k < 4; ++k) { const float a = t1[k] * rinv * g1[k], b = t2[k] * rinv * g2[k]; o1[k] = a * cc[k] - b * sv[k]; o2[k] = b * cc[k] + a * sv[k]; }
        *(u32x4*)(p + 16 * l) = w0; *(u32x4*)(p + 16 * l + 8) = w1;
        u32x2 r1, r2; r1.x = pk2(o1[0], o1[1]); r1.y = pk2(o1[2], o1[3]); r2.x = pk2(o2[0], o2[1]); r2.y = pk2(o2[2], o2[3]);
        *(u32x2*)(p + 128 + 4 * l) = r1; *(u32x2*)(p + 160 + 4 * l) = r2;
    }
}
struct Args { const void* in[18]; float* out; unsigned char* ws; };
enum { I_X = 0, I_POS, I_ANG, I_AWIN, I_AWG, I_ASC, I_AWOUT, I_KVNG, I_KVWA, I_KVLG, I_KVWB, I_KNG, I_BNG, I_BWIN, I_BQLG, I_BWQB, I_BQNG, I_BWOUT };

#define GEMM_RUN_M(EPI, M_, gA, gB, N_, K_, LDA, LDB, AGD, AGS, BGD, BGS, ...) do { \
    pg8::Gemm g_{(const bf16_t*)(gA), (const bf16_t*)(gB), (M_), (N_), (K_), (LDA), (LDB), (AGD), (AGS), (BGD), (BGS)}; pg8::StaticOrder S_; S_.init((M_), (N_), (int)gridDim.x, (int)blockIdx.x); \
    EPI E_{__VA_ARGS__}; pg8::gemm_phase<EPI, pg8::StaticOrder, EPI::ALIGN, true>(c.lds, g_, S_, E_); } while (0)
#define GEMM_RUN(EPI, gA, gB, N_, K_, LDA, LDB, AGD, AGS, ...) GEMM_RUN_M(EPI, MTOK, gA, gB, N_, K_, LDA, LDB, AGD, AGS, NOGRP, 0, __VA_ARGS__)
constexpr int NOGRP = 1 << 30;

typedef const __attribute__((address_space(4))) Args* ArgsP;
__device__ __forceinline__ ArgsP get_args() { auto p = __builtin_amdgcn_kernarg_segment_ptr(); asm volatile("" : "+s"(p)); return (ArgsP)p; }
__device__ __forceinline__ Ctx make_ctx(unsigned char* lds_raw) {
    Ctx c; int tid = threadIdx.x; asm volatile("" : "+v"(tid)); c.tid = tid; c.lane = tid & 63; c.wave = __builtin_amdgcn_readfirstlane(tid >> 6); c.gw = blockIdx.x * 8 + c.wave; c.ngw = gridDim.x * 8; c.lds = (LAS unsigned char*)lds_raw; return c;
}
#define PHASE_BEGIN ArgsP ap = get_args(); unsigned char* ws = ap->ws; const Ctx c = make_ctx(lds_raw); (void)ws; (void)c;
#define INF(k) ((const float*)ap->in[k])
#define WSB(off) ((bf16_t*)(ws + (off)))
#define WSF(off) ((float*)(ws + (off)))

#define GRID_BAR() do { ArgsP ap_ = get_args(); XcdBarrier b_; b_.bar = (unsigned*)(ap_->ws + WS_BAR); b_.x = xb_xcc_id(); b_.st = (volatile LAS unsigned*)((LAS unsigned char*)lds_raw + MISC_OFF); xcd_barrier(b_); } while (0)

__global__ void __launch_bounds__(512, 2) yoco_fwd(Args a_unused) {
    extern __shared__ __attribute__((aligned(16))) unsigned char lds_raw[];
    cg::grid_group grid = cg::this_grid();
    if (threadIdx.x < 2) ((LAS unsigned*)((LAS unsigned char*)lds_raw + MISC_OFF))[threadIdx.x] = 0u;
    { ArgsP ap_ = get_args(); if (threadIdx.x == 0) (void)xb_add((unsigned*)(ap_->ws + WS_BAR) + XB_XCNT(xb_xcc_id()), 1u); }
    __syncthreads();

    {
        PHASE_BEGIN
        rope_tables(c, (const int*)ap->in[I_POS], WSF(WS_COS), WSF(WS_SIN));
        { float* z = WSF(WS_SSQC); for (int i = c.gw * 64 + c.lane; i < 3 * MTOK; i += c.ngw * 64) z[i] = 0.f; }
        { float* z = WSF(WS_SSQX) + MTOK; for (int i = c.gw * 64 + c.lane; i < 4 * MTOK; i += c.ngw * 64) z[i] = 0.f; }
        xprep_rows(c, INF(I_X), (bf16_t*)ap->out, WSF(WS_SSQX));
#pragma unroll 1
        for (int l = 0; l < 2; ++l) {
            const float* win = INF(I_AWIN) + (size_t)l * DM * 2 * WA; const float* gl = INF(I_ANG) + l * DM;
#pragma unroll 1
            for (int g = 0; g < 4; ++g) convert_weight(c, INF(I_AWG) + ((size_t)l * 4 + g) * GA * GA, GA, GA, WSB(WS_AWGB), l * WA + g * GA, nullptr);
            convert_plain(c, win, DM, WA, 2 * WA, WSB(WS_WINUB), 2 * WA, l * WA, gl);
            convert_weight(c, win + WA, DM, WA, WSB(l ? WS_A1WIN : WS_AWIN), WA, gl, 2 * WA);
            convert_weight(c, INF(I_AWOUT) + (size_t)l * WA * DM, WA, DM, WSB(l ? WS_A1WOUT : WS_AWOUT), 0, nullptr);
        }
    }
    if (gridDim.x == 0x7fffffffu) grid.sync();
    GRID_BAR();
    {
        PHASE_BEGIN
        GEMM_RUN_M(EpiWp, 2 * WA, WSB(WS_AWGB), WSB(WS_WINUB), DM, GA, GA, 2 * WA, NOGRP, 0, 4, GA, WSB(WS_AWIN), WSB(WS_A1WIN));
    }
    GRID_BAR();
#pragma unroll 1
    for (int l = 0; l < 2; ++l) {
        {
            PHASE_BEGIN
            GEMM_RUN(EpiA1, (bf16_t*)ap->out + (size_t)l * MTOK * DM, WSB(l ? WS_A1WIN : WS_AWIN), 2 * WA, DM, DM, DM, NOGRP, 0, WSB(l ? WS_R0 : WS_R1), WSB(WS_G), WSF(WS_SSQX) + l * MTOK);
        }
        GRID_BAR();
        {
            PHASE_BEGIN
            pool_phase(c, WSB(l ? WS_R0 : WS_R1), WSB(l ? WS_R1 : WS_R0), WSB(WS_G), INF(I_ASC) + l * WA);
            if (l == 1) {
                bf16_t* WC0 = WSB(WS_BWC0);
                convert_weight(c, INF(I_KVWA), DM, KVL + QKR, WC0, 0, INF(I_KVNG));
                { u32x4* z = (u32x4*)(WC0 + (size_t)(KVL + QKR) * DM); const int n16 = 192 * DM * 2 / 16; for (int i = c.gw * 64 + c.lane; i < n16; i += c.ngw * 64) z[i] = (u32x4){0u, 0u, 0u, 0u}; }
                convert_weight(c, INF(I_BWIN), DM, QL_ + WB, WC0, 768, INF(I_BNG));
            }
        }
        GRID_BAR();
        {
            PHASE_BEGIN
            GEMM_RUN(EpiRes, WSB(l ? WS_R1 : WS_R0), WSB(l ? WS_A1WOUT : WS_AWOUT), DM, WA, WA, WA, NOGRP, 0, (const bf16_t*)ap->out + (size_t)l * MTOK * DM, (float*)nullptr, (bf16_t*)ap->out + (size_t)(1 - l) * MTOK * DM, WSF(WS_SSQX) + (l + 1) * MTOK);
        }
        GRID_BAR();
    }
#pragma unroll 1
    for (int j = 0; j < 2; ++j) {
        {
            PHASE_BEGIN
            float* ssqq = WSF(j ? WS_SSQQ1 : WS_SSQQ0);
            GEMM_RUN(EpiBin, (j ? WSB(WS_XB2) : (bf16_t*)ap->out), WSB(j ? WS_BWIN1 : WS_BWC0), j ? 2560 : 3328, DM, DM, DM, NOGRP, 0, WSB(WS_CB), WSB(WS_QL), WSB(WS_GB), WSF(WS_KR), WSF(WS_SSQC), ssqq, j ? 3 : 0, WSF(WS_SSQX) + (2 + j) * MTOK, WSF(WS_SSQKR));
        }
        {
            PHASE_BEGIN
            if (j == 0) {
                const int G_ = gridDim.x, nfull = (G_ == 256) ? 64 : 0;
                if ((int)blockIdx.x >= nfull) {
                    Ctx c2 = c; c2.gw = ((int)blockIdx.x - nfull) * 8 + c.wave; c2.ngw = (G_ - nfull) * 8;
                    convert_weight(c2, INF(I_BWIN) + (size_t)DM * (QL_ + WB), DM, QL_ + WB, WSB(WS_BWIN1), 0, INF(I_BNG) + DM);
                    convert_weight(c2, INF(I_KVWB), KVL, NH * (QKN + VH), WSB(WS_BWKVB), 0, INF(I_KVLG));
#pragma unroll 1
                    for (int jj = 0; jj < 2; ++jj) {
                        convert_weight(c2, INF(I_BWQB) + (size_t)jj * QL_ * NH * QKH, QL_, NH * QKH, WSB(jj ? WS_BWQB1 : WS_BWQB0), 0, INF(I_BQLG) + jj * QL_);
                        convert_weight(c2, INF(I_BWOUT) + (size_t)jj * WB * DM, WB, DM, WSB(jj ? WS_BWO1 : WS_BWO0), 0, nullptr);
                    }
                }
            }
        }
        GRID_BAR();
        if (j == 0) {
            PHASE_BEGIN
            GEMM_RUN(EpiKVb, WSB(WS_CB), WSB(WS_BWKVB), NH * (QKN + VH), KVL, KVL, KVL, NOGRP, 0, WSB(WS_K), WSB(WS_V), WSF(WS_SSQC), WSF(WS_SSQKR), WSF(WS_KR), INF(I_KNG), WSF(WS_COS), WSF(WS_SIN), (LAS float*)(c.lds + XCH_OFF));
        }
        {
            PHASE_BEGIN
            GEMM_RUN(EpiQb, WSB(WS_QL), WSB(j ? WS_BWQB1 : WS_BWQB0), NH * QKH, QL_, QL_, QL_, NOGRP, 0, WSB(WS_Q), WSF(j ? WS_SSQQ1 : WS_SSQQ0));
        }
        GRID_BAR();
        {
            PHASE_BEGIN
            const int G_ = gridDim.x, bx = blockIdx.x; const int vcu = (G_ % 8 == 0) ? (bx % 8) * (G_ / 8) + bx / 8 : bx;
#pragma unroll 1
            for (int slot = vcu; slot < 256; slot += G_) {
                const int bh = slot >> 2, s = slot & 3, b = bh >> 4, h = bh & 15;
#pragma unroll 1
                for (int i = 0; i < 4; ++i) {
                    const int qb = (i == 0) ? 15 - s : (i == 1) ? 8 + s : (i == 2) ? 7 - s : s;
                    att::attn_unit(WSB(WS_Q) + (size_t)bh * SEQ * QKH, WSB(WS_K) + (size_t)bh * SEQ * QKH, WSB(WS_V) + (size_t)bh * SEQ * VH,
                                   WSB(WS_GB) + (size_t)b * SEQ * WB + h * VH, WSB(WS_OG) + (size_t)b * SEQ * WB + h * VH, qb, (char*)lds_raw,
                                   INF(I_BQNG) + j * QKH, WSF(WS_COS) + (size_t)b * SEQ * 32, WSF(WS_SIN) + (size_t)b * SEQ * 32);
                }
            }
        }
        GRID_BAR();
        {
            PHASE_BEGIN
            GEMM_RUN(EpiRes, WSB(WS_OG), WSB(j ? WS_BWO1 : WS_BWO0), DM, WB, WB, WB, NOGRP, 0, (j ? (const bf16_t*)WSB(WS_XB2) : (const bf16_t*)ap->out), (j ? ap->out : (float*)nullptr), (j == 0 ? WSB(WS_XB2) : (bf16_t*)nullptr), WSF(WS_SSQX) + 3 * MTOK);
        }
        if (j == 0) GRID_BAR();
    }
}

extern "C" void kernel_launch(void* const* d_in, const int* in_sizes, int n_in, void* d_out, int out_size, void* d_ws, size_t ws_size, hipStream_t stream) {
    static int grid_blocks = 0;
    if (grid_blocks == 0) {
        if (n_in != 18 || out_size != MTOK * DM || ws_size < WS_END) { fprintf(stderr, "kernel_launch: unexpected shapes n_in %d out %d ws %zu (need %zu)\n", n_in, out_size, ws_size, (size_t)WS_END); grid_blocks = -1; return; }
        int dev = 0, cus = 0, per_cu = 0;
        (void)hipGetDevice(&dev); (void)hipDeviceGetAttribute(&cus, hipDeviceAttributeMultiprocessorCount, dev);
        if (hipFuncSetAttribute((const void*)yoco_fwd, hipFuncAttributeMaxDynamicSharedMemorySize, LDS_BYTES) != hipSuccess) { fprintf(stderr, "kernel_launch: hipFuncSetAttribute failed\n"); grid_blocks = -1; return; }
        if (hipOccupancyMaxActiveBlocksPerMultiprocessor(&per_cu, (const void*)yoco_fwd, 512, LDS_BYTES) != hipSuccess || per_cu < 1) { fprintf(stderr, "kernel_launch: occupancy query gave %d\n", per_cu); per_cu = 1; }
        (void)hipGetLastError();
        grid_blocks = cus * 1;
        fprintf(stderr, "kernel_launch: cus %d per_cu %d grid %d ws %zu\n", cus, per_cu, grid_blocks, ws_size);
    }
    if (grid_blocks < 0) return;
    if (hipMemsetAsync((char*)d_ws + WS_BAR, 0, XCD_BAR_WORDS * 4, stream) != hipSuccess) { fprintf(stderr, "kernel_launch: hipMemsetAsync failed\n"); return; }
    Args a{};
    for (int i = 0; i < 18; ++i) a.in[i] = d_in[i];
    a.out = (float*)d_out; a.ws = (unsigned char*)d_ws;
    void* args[] = {&a};
    hipError_t e = hipLaunchCooperativeKernel((const void*)yoco_fwd, dim3(grid_blocks), dim3(512), args, LDS_BYTES, stream);
    if (e != hipSuccess) fprintf(stderr, "cooperative launch failed: %s (grid %d)\n", hipGetErrorString(e), grid_blocks);
}
```

```cpp
#include <hip/hip_runtime.h>
#include <hip/hip_cooperative_groups.h>
#include <hip/hip_bf16.h>
#include <cstdio>
#include <cstdint>
namespace cg = cooperative_groups;

namespace pg8 {
#define PG8_LAS __attribute__((address_space(3)))
typedef unsigned short bf16_t;
typedef short bf16x8 __attribute__((ext_vector_type(8)));
typedef float f32x4 __attribute__((ext_vector_type(4)));
typedef unsigned u32x4 __attribute__((ext_vector_type(4)));
constexpr int BM = 256, BK = 64, HALF = 128, HTB = HALF * BK * 2  , STAGE_BYTES = 8 * HTB, NXCD = 8, WGM = 8;

__host__ __device__ __forceinline__ int lds_byte(int r, int c) { const int st = (r >> 4) * 2 + (c >> 5), rr = r & 15, cc = c & 31, ob = rr * 64 + cc * 2; return st * 1024 + (ob ^ (((ob >> 9) & 1) << 5)); }
__host__ __device__ __forceinline__ void stage_rc(int b, int& R, int& C) { const int st = b / 1024, sb = b % 1024, swz = sb ^ (((sb >> 9) & 1) << 5); R = (st >> 1) * 16 + swz / 64; C = (st & 1) * 32 + (swz % 64) / 2; }
__host__ __device__ __forceinline__ int perm32(int rho) { const int n = rho >> 4, i = rho & 15; return 8 * (i >> 2) + 4 * n + (i & 3); }

struct Unit { int pm, pn; };
struct Gemm { const bf16_t* A; const bf16_t* Bt; int M, N, K, lda, ldb, agdiv, agstep, bgdiv, bgstep; };

struct StaticOrder {
    int nM, nN, nwg, G, c;
    __host__ __device__ void init(int M, int N, int G_, int c_) { nM = M / BM; nN = N / BM; nwg = nM * nN; G = G_; c = c_; }
    __host__ __device__ bool next(int i, Unit& u) const {
        const long L = (long)i * G + c; if (L >= nwg) return false;
        int wgid = (int)L; { const int q = nwg / NXCD, r = nwg % NXCD, xcd = wgid % NXCD, off = wgid / NXCD; wgid = (xcd < r ? xcd * (q + 1) : r * (q + 1) + (xcd - r) * q) + off; }
        const int nig = WGM * nN, gid = wgid / nig, fm = gid * WGM, gsz = (nM - fm) < WGM ? (nM - fm) : WGM;
        u.pm = fm + ((wgid % nig) % gsz); u.pn = (wgid % nig) / gsz; return true;
    }
    __device__ __forceinline__ void a_ready(const Unit&) const {}
    __device__ __forceinline__ void done(const Unit&) const {}
};

#define PG8_UA(u) ((const char*)g.A + (size_t)(u).pm * tstepA + (size_t)((u).pn / g.agdiv) * (size_t)g.agstep * 2)
#define PG8_UB(u) ((const char*)g.Bt + (size_t)(u).pn * tstepB + (size_t)((u).pm / g.bgdiv) * (size_t)g.bgstep * 2)
template <class Epi, class Sched, bool ALIGN_EPI = false, bool SP2 = false>
__device__ __forceinline__ void gemm_phase(PG8_LAS unsigned char* lds, const Gemm g, const Sched& S, const Epi& E) {
    int tid_l = threadIdx.x; asm volatile("" : "+v"(tid_l));
    const int tid = tid_l, wid = __builtin_amdgcn_readfirstlane(tid >> 6), lane = tid & 63, wr = wid >> 2, wc = wid & 3, fr = lane & 15, fq = lane >> 4;
    const int K = g.K, nt = K / BK;
    unsigned voffA[2], voffB[2];
#pragma unroll
    for (int i = 0; i < 2; ++i) { int R, C; stage_rc(tid * 16 + i * 8192, R, C); const int Rb = Epi::PERM ? ((R & ~31) + perm32(R & 31)) : R;
        voffA[i] = (unsigned)(R * g.lda + C) * 2u; voffB[i] = (unsigned)(Rb * g.ldb + C) * 2u; }
    const size_t kstep = (size_t)(BK * 2);
    const size_t hstepA = (size_t)HALF * g.lda * 2, hstepB = (size_t)HALF * g.ldb * 2;
    const size_t tstepA = 2 * hstepA, tstepB = 2 * hstepB;
    const unsigned ldsw = (unsigned)wid * 1024u;
    const int aoff = lds_byte(wr * 64 + fr, fq * 8), boff = lds_byte(wc * 32 + fr, fq * 8);
#define PG8_SA(b, h) (((b) * 2 + (h)) * HTB)
#define PG8_SB(b, h) ((4 + (b) * 2 + (h)) * HTB)
#define PG8_STAGE(bufoff, gbase, voff) do { _Pragma("unroll") for (int _i = 0; _i < 2; ++_i) \
        __builtin_amdgcn_global_load_lds((const unsigned*)((const char*)(gbase) + (voff)[_i]), (PG8_LAS unsigned*)(lds + (bufoff) + ldsw + _i * 8192), 16, 0, 0); } while (0)
#define PG8_LDA(dst, b, h) do { _Pragma("unroll") for (int m = 0; m < 4; ++m) _Pragma("unroll") for (int k = 0; k < 2; ++k) dst[m][k] = *(const PG8_LAS bf16x8*)(lds + PG8_SA(b, h) + aoff + m * 2048 + k * 1024); } while (0)
#define PG8_LDB(dst, b, h) do { _Pragma("unroll") for (int n = 0; n < 2; ++n) _Pragma("unroll") for (int k = 0; k < 2; ++k) dst[n][k] = *(const PG8_LAS bf16x8*)(lds + PG8_SB(b, h) + boff + n * 2048 + k * 1024); } while (0)
#define PG8_MMA(ai, bj, At, Bt) do { __builtin_amdgcn_s_setprio(1); _Pragma("unroll") for (int m = 0; m < 4; ++m) _Pragma("unroll") for (int n = 0; n < 2; ++n) _Pragma("unroll") for (int k = 0; k < 2; ++k) \
        acc[ai][bj][m][n] = __builtin_amdgcn_mfma_f32_16x16x32_bf16(Bt[n][k], At[m][k], acc[ai][bj][m][n], 0, 0, 0); __builtin_amdgcn_s_setprio(0); } while (0)
#define PG8_WAIT_V(n) asm volatile("s_waitcnt vmcnt(" #n ")" ::: "memory")
#define PG8_WAIT_L(n) asm volatile("s_waitcnt lgkmcnt(" #n ")" ::: "memory")
#define PG8_BAR __builtin_amdgcn_s_barrier()
#define PG8_SCHED __builtin_amdgcn_sched_barrier(0)
    Unit cur, nxt; int ui = 0;
    if (!S.next(0, cur)) return;
    f32x4 acc[2][2][4][2];
#pragma unroll
    for (int a = 0; a < 2; ++a)
#pragma unroll
        for (int b = 0; b < 2; ++b)
#pragma unroll
            for (int m = 0; m < 4; ++m)
#pragma unroll
                for (int n = 0; n < 2; ++n) acc[a][b][m][n] = (f32x4){0.f, 0.f, 0.f, 0.f};
    bf16x8 At[4][2], B0[2][2], B1[2][2];
    const char* cA = PG8_UA(cur); const char* cB = PG8_UB(cur);
    S.a_ready(cur);
    if constexpr (SP2) {
        PG8_STAGE(PG8_SB(0, 0), cB, voffB); PG8_STAGE(PG8_SB(0, 1), cB + hstepB, voffB); PG8_STAGE(PG8_SA(0, 0), cA, voffA); PG8_STAGE(PG8_SA(0, 1), cA + hstepA, voffA);
        if (wr == 1) PG8_BAR;
        PG8_WAIT_V(2); PG8_BAR;
        PG8_STAGE(PG8_SB(1, 0), cB + kstep, voffB); PG8_STAGE(PG8_SA(1, 0), cA + kstep, voffA); PG8_STAGE(PG8_SB(1, 1), cB + hstepB + kstep, voffB);
        PG8_WAIT_V(6); PG8_BAR;
    } else {
        PG8_STAGE(PG8_SB(0, 0), cB, voffB); PG8_STAGE(PG8_SA(0, 0), cA, voffA); PG8_STAGE(PG8_SB(0, 1), cB + hstepB, voffB); PG8_STAGE(PG8_SA(0, 1), cA + hstepA, voffA);
        if (wr == 1) PG8_BAR;
        PG8_WAIT_V(4); PG8_BAR;
        PG8_STAGE(PG8_SB(1, 0), cB + kstep, voffB); PG8_STAGE(PG8_SA(1, 0), cA + kstep, voffA); PG8_STAGE(PG8_SB(1, 1), cB + hstepB + kstep, voffB);
        PG8_WAIT_V(6); PG8_BAR;
    }
    for (;;) {
        const bool has_next = S.next(ui + 1, nxt);
        const char* nA = has_next ? PG8_UA(nxt) : cA; const char* nB = has_next ? PG8_UB(nxt) : cB;
        for (int t = 0; t < nt; t += 2) {
            const bool last = (t == nt - 2);
            const char* a1 = cA + (size_t)(t + 1) * kstep;
            const char* a2 = last ? nA : cA + (size_t)(t + 2) * kstep; const char* b2 = last ? nB : cB + (size_t)(t + 2) * kstep;
            const char* a3 = a2 + kstep; const char* b3 = b2 + kstep;
            if (last && has_next) S.a_ready(nxt);
            if constexpr (SP2) {
            PG8_LDB(B0, 0, 0); PG8_LDB(B1, 0, 1); PG8_SCHED; PG8_LDA(At, 0, 0); PG8_STAGE(PG8_SA(1, 1), a1 + hstepA, voffA);
            PG8_WAIT_V(8); PG8_WAIT_L(0); PG8_BAR; PG8_MMA(0, 0, At, B0); PG8_MMA(0, 1, At, B1); PG8_BAR; PG8_SCHED;
            PG8_LDA(At, 0, 1); PG8_STAGE(PG8_SB(0, 0), b2, voffB); PG8_STAGE(PG8_SB(0, 1), b2 + hstepB, voffB); PG8_STAGE(PG8_SA(0, 0), a2, voffA);
            PG8_WAIT_V(8); PG8_WAIT_L(0); PG8_BAR; PG8_MMA(1, 0, At, B0); PG8_MMA(1, 1, At, B1); PG8_BAR; PG8_SCHED;
            PG8_LDB(B0, 1, 0); PG8_LDB(B1, 1, 1); PG8_SCHED; PG8_LDA(At, 1, 0); PG8_STAGE(PG8_SA(0, 1), a2 + hstepA, voffA);
            PG8_WAIT_V(8); PG8_WAIT_L(0); PG8_BAR; PG8_MMA(0, 0, At, B0); PG8_MMA(0, 1, At, B1); PG8_BAR; PG8_SCHED;
            PG8_LDA(At, 1, 1); PG8_STAGE(PG8_SB(1, 0), b3, voffB); PG8_STAGE(PG8_SB(1, 1), b3 + hstepB, voffB); PG8_STAGE(PG8_SA(1, 0), a3, voffA);
            PG8_WAIT_V(8); PG8_WAIT_L(0); PG8_BAR; PG8_MMA(1, 0, At, B0); PG8_MMA(1, 1, At, B1); PG8_BAR; PG8_SCHED;
            } else {
            PG8_LDB(B0, 0, 0); PG8_SCHED; PG8_LDA(At, 0, 0); PG8_STAGE(PG8_SA(1, 1), a1 + hstepA, voffA);
            PG8_WAIT_L(8); PG8_BAR; PG8_WAIT_L(0); PG8_MMA(0, 0, At, B0); PG8_BAR; PG8_SCHED;
            PG8_LDB(B1, 0, 1); PG8_STAGE(PG8_SB(0, 0), b2, voffB);
            PG8_BAR; PG8_WAIT_L(0); PG8_MMA(0, 1, At, B1); PG8_BAR;
            PG8_LDA(At, 0, 1); PG8_STAGE(PG8_SA(0, 0), a2, voffA);
            PG8_BAR; PG8_WAIT_L(0); PG8_MMA(1, 0, At, B0); PG8_BAR; PG8_SCHED;
            PG8_STAGE(PG8_SB(0, 1), b2 + hstepB, voffB);
            PG8_WAIT_V(6); PG8_BAR; PG8_MMA(1, 1, At, B1); PG8_BAR;
            PG8_LDB(B0, 1, 0); PG8_SCHED; PG8_LDA(At, 1, 0); PG8_STAGE(PG8_SA(0, 1), a2 + hstepA, voffA);
            PG8_WAIT_L(8); PG8_BAR; PG8_WAIT_L(0); PG8_MMA(0, 0, At, B0); PG8_BAR; PG8_SCHED;
            PG8_LDB(B1, 1, 1); PG8_STAGE(PG8_SB(1, 0), b3, voffB);
            PG8_BAR; PG8_WAIT_L(0); PG8_MMA(0, 1, At, B1); PG8_BAR;
            PG8_LDA(At, 1, 1); PG8_STAGE(PG8_SA(1, 0), a3, voffA);
            PG8_BAR; PG8_WAIT_L(0); PG8_MMA(1, 0, At, B0); PG8_BAR; PG8_SCHED;
            PG8_STAGE(PG8_SB(1, 1), b3 + hstepB, voffB);
            PG8_WAIT_V(6); PG8_BAR; PG8_MMA(1, 1, At, B1); PG8_BAR;
            }
        }
        if constexpr (ALIGN_EPI) { if (wr == 0) PG8_BAR; }
        if constexpr (!Epi::AFTER_DRAIN) { E(acc, cur, wr, wc, fr, fq); S.done(cur); }
        if (!has_next) break;
#pragma unroll
        for (int a = 0; a < 2; ++a)
#pragma unroll
            for (int b = 0; b < 2; ++b)
#pragma unroll
                for (int m = 0; m < 4; ++m)
#pragma unroll
                    for (int n = 0; n < 2; ++n) acc[a][b][m][n] = (f32x4){0.f, 0.f, 0.f, 0.f};
        cur = nxt; cA = nA; cB = nB; ++ui;
        if constexpr (ALIGN_EPI) { if (wr == 1) PG8_BAR; }
    }
    PG8_WAIT_V(0);
    if constexpr (!ALIGN_EPI) { if (wr == 0) PG8_BAR; }
    PG8_BAR;
    if constexpr (Epi::AFTER_DRAIN) { E.fused(acc, cur, wr, wc, fr, fq, lds, wid, lane); S.done(cur); }
#undef PG8_SA
#undef PG8_SB
#undef PG8_STAGE
#undef PG8_LDA
#undef PG8_LDB
#undef PG8_MMA
#undef PG8_WAIT_V
#undef PG8_WAIT_L
#undef PG8_BAR
#undef PG8_SCHED
}
}

constexpr int DM = 2048, NB = 4, SEQ = 4096, MTOK = NB * SEQ;
constexpr int WA = 4096, GA = 1024, NH = 16, QKN = 128, QKR = 64, QKH = 192, VH = 128, KVL = 512, QL_ = 512, WB = 2048;
constexpr float EPS = 1e-6f;

typedef unsigned short bf16_t;
typedef float f32x4 __attribute__((ext_vector_type(4)));
typedef unsigned u32x4 __attribute__((ext_vector_type(4)));
typedef unsigned u32x2 __attribute__((ext_vector_type(2)));
typedef short bf16x8 __attribute__((ext_vector_type(8)));
#define LAS __attribute__((address_space(3)))

constexpr size_t MiB = 1u << 20;
constexpr size_t WS_COS = 0, WS_SIN = 2 * MiB, WS_SSQC = 4 * MiB, WS_SSQQ0 = 4 * MiB + 65536, WS_SSQQ1 = 4 * MiB + 131072, WS_SSQX = 4 * MiB + 196608  , WS_SSQKR = 4 * MiB + 458752  , WS_KR = 5 * MiB;
constexpr size_t WS_BAR = 9 * MiB;
constexpr size_t WS_W = 10 * MiB;
constexpr size_t WS_AWIN = WS_W, WS_AWG = WS_W + 32 * MiB, WS_AWOUT = WS_W + 40 * MiB;
constexpr size_t WS_BWC0 = WS_W, WS_BWIN1 = WS_W + 13 * MiB, WS_BWKVB = WS_W + 23 * MiB, WS_BWQB0 = WS_W + 27 * MiB, WS_BWQB1 = WS_W + 30 * MiB, WS_BWO0 = WS_W + 33 * MiB, WS_BWO1 = WS_W + 41 * MiB;
constexpr size_t WS_ACT = 66 * MiB;
constexpr size_t WS_XN = WS_ACT, WS_R0 = WS_ACT, WS_R1 = WS_ACT + 128 * MiB, WS_G = WS_ACT + 256 * MiB;
constexpr size_t WS_AWGB = WS_G, WS_WINUB = WS_G + 16 * MiB;
constexpr size_t WS_GB = WS_ACT + 64 * MiB, WS_OG = WS_GB  , WS_CB = WS_ACT + 128 * MiB, WS_QL = WS_ACT + 144 * MiB, WS_K = WS_ACT + 160 * MiB, WS_V = WS_ACT + 256 * MiB, WS_Q = WS_ACT + 320 * MiB;
constexpr size_t WS_W2 = 450 * MiB, WS_A1WIN = WS_W2, WS_A1WG = WS_W2 + 32 * MiB, WS_A1WOUT = WS_W2 + 40 * MiB;
constexpr size_t WS_XB2 = WS_ACT;
constexpr size_t WS_END = 506 * MiB;
constexpr int LDS_BYTES = 131072 + 8192, XCH_OFF = 131072  , MISC_OFF = 131072 + 4096;

__device__ __forceinline__ unsigned f2bf(float f) { unsigned u = __builtin_bit_cast(unsigned, f); return (u + 0x7fffu + ((u >> 16) & 1u)) >> 16; }
__device__ __forceinline__ unsigned pk2(float lo, float hi) { unsigned r; asm volatile("v_cvt_pk_bf16_f32 %0, %1, %2" : "=v"(r) : "v"(lo), "v"(hi)); return r; }
__device__ __forceinline__ float bflo(unsigned w) { return __builtin_bit_cast(float, w << 16); }
__device__ __forceinline__ float bfhi(unsigned w) { return __builtin_bit_cast(float, w & 0xffff0000u); }
__device__ __forceinline__ float silu_f(float v) { return v * __builtin_amdgcn_rcpf(1.0f + __builtin_amdgcn_exp2f(-1.4426950408889634f * v)); }
__device__ __forceinline__ float sum_fq(float v) {
    { auto rr = __builtin_amdgcn_permlane16_swap(__float_as_uint(v), __float_as_uint(v), false, false); v = __uint_as_float(rr[0]) + __uint_as_float(rr[1]); }
    { auto rr = __builtin_amdgcn_permlane32_swap(__float_as_uint(v), __float_as_uint(v), false, false); v = __uint_as_float(rr[0]) + __uint_as_float(rr[1]); }
    return v;
}
__device__ __forceinline__ float wave_sum(float v) {
#pragma unroll
    for (int o = 1; o < 64; o <<= 1) v += __shfl_xor(v, o);
    return v;
}

typedef const f32x4 (&AccT)[2][2][4][2];
#define EPI_ROWS(...) _Pragma("unroll") for (int ai = 0; ai < 2; ++ai) _Pragma("unroll") for (int m = 0; m < 4; ++m) { const int row = u.pm * 256 + ai * 128 + wr * 64 + m * 16 + fr; __VA_ARGS__ }
__device__ __forceinline__ u32x4 pack8(f32x4 a, f32x4 b) { u32x4 w; w.x = pk2(a[0], a[1]); w.y = pk2(a[2], a[3]); w.z = pk2(b[0], b[1]); w.w = pk2(b[2], b[3]); return w; }
__device__ __forceinline__ f32x4 silu4(f32x4 v) { return (f32x4){silu_f(v[0]), silu_f(v[1]), silu_f(v[2]), silu_f(v[3])}; }

struct EpiA1 {
    static constexpr bool PERM = true, AFTER_DRAIN = false, ALIGN = true;
    bf16_t* U; bf16_t* G; const float* ssqx;
    __device__ __forceinline__ void operator()(AccT acc, const pg8::Unit& u, int wr, int wc, int fr, int fq) const {
        const bool isg = u.pn >= 16; bf16_t* base = isg ? G : U; const int col0 = (isg ? u.pn - 16 : u.pn) * 256 + wc * 32 + fq * 8;
        EPI_ROWS(
            const float rx = 1.0f / sqrtf(ssqx[row] * (1.0f / DM) + EPS);
            _Pragma("unroll") for (int bj = 0; bj < 2; ++bj) { f32x4 v0 = acc[ai][bj][m][0] * rx, v1 = acc[ai][bj][m][1] * rx;
                if (isg) { v0 = silu4(v0); v1 = silu4(v1); }
                *(u32x4*)(base + (size_t)row * WA + col0 + bj * 128) = pack8(v0, v1); }
        )
    }
};
struct EpiWp {
    static constexpr bool PERM = true, AFTER_DRAIN = false, ALIGN = true;
    bf16_t* o0; bf16_t* o1;
    __device__ __forceinline__ void operator()(AccT acc, const pg8::Unit& u, int wr, int wc, int fr, int fq) const {
        const int col0 = u.pn * 256 + wc * 32 + fq * 8;
        EPI_ROWS(
            bf16_t* base = (row < WA ? o0 : o1) + (size_t)(row & (WA - 1)) * DM + col0;
            _Pragma("unroll") for (int bj = 0; bj < 2; ++bj) *(u32x4*)(base + bj * 128) = pack8(acc[ai][bj][m][0], acc[ai][bj][m][1]);
        )
    }
};
struct EpiRes {
    static constexpr bool PERM = true, AFTER_DRAIN = false, ALIGN = true;
    const bf16_t* res; float* out; bf16_t* xb; float* ssq;
    __device__ __forceinline__ void operator()(AccT acc, const pg8::Unit& u, int wr, int wc, int fr, int fq) const {
        const int col0 = u.pn * 256 + wc * 32 + fq * 8;
        EPI_ROWS(
            float s = 0.f;
            _Pragma("unroll") for (int bj = 0; bj < 2; ++bj) { const size_t off = (size_t)row * DM + col0 + bj * 128;
                const u32x4 rb = __builtin_nontemporal_load((const u32x4*)(res + off));
                const f32x4 r0 = (f32x4){bflo(rb.x), bfhi(rb.x), bflo(rb.y), bfhi(rb.y)} + acc[ai][bj][m][0], r1 = (f32x4){bflo(rb.z), bfhi(rb.z), bflo(rb.w), bfhi(rb.w)} + acc[ai][bj][m][1];
                if (out) { *(f32x4*)(out + off) = r0; *(f32x4*)(out + off + 4) = r1; }
                if (xb) { *(u32x4*)(xb + off) = pack8(r0, r1);
                    s += (r0[0] * r0[0] + r0[1] * r0[1]) + (r0[2] * r0[2] + r0[3] * r0[3]) + (r1[0] * r1[0] + r1[1] * r1[1]) + (r1[2] * r1[2] + r1[3] * r1[3]); } }
            if (xb) { s = sum_fq(s); if (fq == 0) atomicAdd(ssq + row, s); }
        )
    }
};
struct EpiBin {
    static constexpr bool PERM = true, AFTER_DRAIN = false, ALIGN = true;
    bf16_t* Cb; bf16_t* QL; bf16_t* Gb; float* KR; float* ssqc; float* ssqq; int toff; const float* ssqx; float* ssqkr;
    __device__ __forceinline__ void operator()(AccT acc, const pg8::Unit& u, int wr, int wc, int fr, int fq) const {
        const int t = u.pn + toff; const int cw = wc * 32 + fq * 8;
        if (t >= 5) {
            const int col0 = (t - 5) * 256 + cw;
            EPI_ROWS(
                const float rx = 1.0f / sqrtf(ssqx[row] * (1.0f / DM) + EPS);
                _Pragma("unroll") for (int bj = 0; bj < 2; ++bj)
                    *(u32x4*)(Gb + (size_t)row * WB + col0 + bj * 128) = pack8(silu4(acc[ai][bj][m][0] * rx), silu4(acc[ai][bj][m][1] * rx));
            )
        } else if (t == 2) {
            if (wc < 2) {
                EPI_ROWS(
                    const float rx = 1.0f / sqrtf(ssqx[row] * (1.0f / DM) + EPS);
                    const f32x4 v0 = acc[ai][0][m][0] * rx, v1 = acc[ai][0][m][1] * rx;
                    *(f32x4*)(KR + (size_t)row * 64 + cw) = v0; *(f32x4*)(KR + (size_t)row * 64 + cw + 4) = v1;
                    float s = (v0[0] * v0[0] + v0[1] * v0[1]) + (v0[2] * v0[2] + v0[3] * v0[3]) + (v1[0] * v1[0] + v1[1] * v1[1]) + (v1[2] * v1[2] + v1[3] * v1[3]);
                    s = sum_fq(s);
                    if (fq == 0) atomicAdd(ssqkr + row, s);
                )
            }
        } else {
            const bool isq = t >= 3; bf16_t* base = isq ? QL : Cb; float* ssq = isq ? ssqq : ssqc; const int col0 = (isq ? t - 3 : t) * 256 + cw;
            EPI_ROWS(
                float s = 0.f; const float rx = 1.0f / sqrtf(ssqx[row] * (1.0f / DM) + EPS);
                _Pragma("unroll") for (int bj = 0; bj < 2; ++bj) { const f32x4 v0 = acc[ai][bj][m][0] * rx, v1 = acc[ai][bj][m][1] * rx;
                    s += (v0[0] * v0[0] + v0[1] * v0[1]) + (v0[2] * v0[2] + v0[3] * v0[3]) + (v1[0] * v1[0] + v1[1] * v1[1]) + (v1[2] * v1[2] + v1[3] * v1[3]);
                    *(u32x4*)(base + (size_t)row * 512 + col0 + bj * 128) = pack8(v0, v1); }
                s = sum_fq(s);
                if (fq == 0) atomicAdd(ssq + row, s);
            )
        }
    }
};
struct EpiKVb {
    static constexpr bool PERM = true, AFTER_DRAIN = false, ALIGN = true;
    bf16_t* K; bf16_t* V; const float* ssqc; const float* ssqkr; const float* KR; const float* gk; const float* cs; const float* sn; LAS float* xch;
    __device__ __forceinline__ void operator()(AccT acc, const pg8::Unit& u, int wr, int wc, int fr, int fq) const {
        const int cw = wc * 32 + fq * 8;
        float rc[2][4];
#pragma unroll
        for (int ai = 0; ai < 2; ++ai)
#pragma unroll
            for (int m = 0; m < 4; ++m) { const int rt = ai * 128 + wr * 64 + m * 16 + fr, row = u.pm * 256 + rt;
                rc[ai][m] = 1.0f / sqrtf(ssqc[row] * (1.0f / KVL) + EPS);
                const f32x4 v0 = acc[ai][0][m][0], v1 = acc[ai][0][m][1];
                float s = (v0[0] * v0[0] + v0[1] * v0[1]) + (v0[2] * v0[2] + v0[3] * v0[3]) + (v1[0] * v1[0] + v1[1] * v1[1]) + (v1[2] * v1[2] + v1[3] * v1[3]);
                s = sum_fq(s);
                if (fq == 0) xch[rt * 4 + wc] = s * rc[ai][m] * rc[ai][m]; }
        asm volatile("s_waitcnt lgkmcnt(0)" ::: "memory"); __builtin_amdgcn_s_barrier(); asm volatile("" ::: "memory");
        const f32x4 g0 = *(const f32x4*)(gk + cw), g1 = *(const f32x4*)(gk + cw + 4);
        const int i0 = (wc * 4 + fq) * 2;
        const float ga0 = gk[128 + i0], ga1 = gk[129 + i0], gb0 = gk[160 + i0], gb1 = gk[161 + i0];
#pragma unroll
        for (int ai = 0; ai < 2; ++ai)
#pragma unroll
            for (int m = 0; m < 4; ++m) { const int rt = ai * 128 + wr * 64 + m * 16 + fr, row = u.pm * 256 + rt;
                const f32x4 pp = *(const LAS f32x4*)(xch + rt * 4);
                const float rk = 1.0f / sqrtf(((pp[0] + pp[1]) + (pp[2] + pp[3]) + ssqkr[row]) * (1.0f / QKH) + EPS), rcv = rc[ai][m], rn = rcv * rk;
                const size_t R = (size_t)((row >> 12) * NH + u.pn) * SEQ + (row & (SEQ - 1));
                *(u32x4*)(K + R * QKH + cw) = pack8(acc[ai][0][m][0] * rn * g0, acc[ai][0][m][1] * rn * g1);
                *(u32x4*)(V + R * VH + cw) = pack8(acc[ai][1][m][0] * rcv, acc[ai][1][m][1] * rcv);
                const float a0 = KR[(size_t)row * 64 + i0] * rk * ga0, a1 = KR[(size_t)row * 64 + i0 + 1] * rk * ga1, b0 = KR[(size_t)row * 64 + 32 + i0] * rk * gb0, b1 = KR[(size_t)row * 64 + 33 + i0] * rk * gb1;
                const float c0 = cs[(size_t)row * 32 + i0], c1 = cs[(size_t)row * 32 + i0 + 1], s0 = sn[(size_t)row * 32 + i0], s1 = sn[(size_t)row * 32 + i0 + 1];
                *(unsigned*)(K + R * QKH + 128 + i0) = pk2(a0 * c0 - b0 * s0, a1 * c1 - b1 * s1);
                *(unsigned*)(K + R * QKH + 160 + i0) = pk2(b0 * c0 + a0 * s0, b1 * c1 + a1 * s1); }
    }
};
struct EpiQb {
    static constexpr bool PERM = true, AFTER_DRAIN = false, ALIGN = true;
    bf16_t* Q; const float* ssqq;
    __device__ __forceinline__ void operator()(AccT acc, const pg8::Unit& u, int wr, int wc, int fr, int fq) const {
        const int col0 = u.pn * 256 + wc * 32 + fq * 8;
        EPI_ROWS(
            const float rinv = 1.0f / sqrtf(ssqq[row] * (1.0f / QL_) + EPS);
            _Pragma("unroll") for (int bj = 0; bj < 2; ++bj) { const int col = col0 + bj * 128, head = col / QKH, d = col - head * QKH;
                const size_t R = (size_t)((row >> 12) * NH + head) * SEQ + (row & (SEQ - 1));
                *(u32x4*)(Q + R * QKH + d) = pack8(acc[ai][bj][m][0] * rinv, acc[ai][bj][m][1] * rinv); }
        )
    }
};
#define RLX_AGENT __ATOMIC_RELAXED, __HIP_MEMORY_SCOPE_AGENT
#define XB_TMO      128
#define XB_XCNT(j)  (256  + 64 * (j))
#define XB_XSUB(j)  (1280 + 64 * (j))
#define XB_XGEN(j)  (2304 + 64 * (j))
#define XB_TOP      3328
#define XB_TOPGEN   3392
#define XCD_BAR_WORDS 3456
#define XB_SPIN_CAP (1u << 18)

__device__ __forceinline__ unsigned xb_ld(unsigned* p)              { return __hip_atomic_load(p, __ATOMIC_RELAXED, __HIP_MEMORY_SCOPE_AGENT); }
__device__ __forceinline__ unsigned xb_add(unsigned* p, unsigned v) { return __hip_atomic_fetch_add(p, v, __ATOMIC_RELAXED, __HIP_MEMORY_SCOPE_AGENT); }
__device__ __forceinline__ unsigned xb_xcc_id() { return (unsigned)__builtin_amdgcn_s_getreg((3 << 11) | 20) & 0xFu; }
#define XB_SPIN(cond, bar) do { unsigned _sp = 0; while (cond) { __builtin_amdgcn_s_sleep(1); \
    if ((++_sp & 255u) == 0u) { if (xb_ld(&(bar)[XB_TMO])) break; if (_sp > XB_SPIN_CAP) { atomicAdd(&(bar)[XB_TMO], 1u); break; } } } } while (0)

struct XcdBarrier {
    unsigned* bar; unsigned x;
    volatile LAS unsigned* st;
};

__device__ __forceinline__ XcdBarrier xcd_barrier_post(unsigned* bar, volatile LAS unsigned* st) {
    XcdBarrier b; b.bar = bar; b.x = xb_xcc_id(); b.st = st;
    if (threadIdx.x == 0) (void)xb_add(&bar[XB_XCNT(b.x)], 1u);
    return b;
}
__device__ __forceinline__ void xcd_barrier_complete(unsigned* bar, unsigned x, unsigned& nloc, unsigned& nx) {
    const unsigned G = gridDim.x * gridDim.y * gridDim.z;
    unsigned sum, cnt, mine, sp = 0u;
    for (;;) {
        sum = 0u; cnt = 0u; mine = 0u;
#pragma unroll
        for (unsigned j = 0; j < 16; ++j) { const unsigned c = xb_ld(&bar[XB_XCNT(j)]); sum += c; cnt += (c > 0u) ? 1u : 0u; mine = (j == x) ? c : mine; }
        if (sum == G) break;
        __builtin_amdgcn_s_sleep(1);
        if ((++sp & 255u) == 0u) { if (xb_ld(&bar[XB_TMO])) break; if (sp > XB_SPIN_CAP) { atomicAdd(&bar[XB_TMO], 1u); break; } }
    }
    nloc = mine > 0u ? mine : 1u; nx = cnt > 0u ? cnt : 1u;
}

__device__ __forceinline__ void xcd_barrier(const XcdBarrier& b) {
    asm volatile("s_waitcnt vmcnt(0)" ::: "memory");
    __syncthreads();
    if (threadIdx.x == 0) {
        unsigned* bar = b.bar;
        __builtin_amdgcn_s_waitcnt(0);
        unsigned nloc = b.st[0], nx = b.st[1];
        if (nloc == 0u) { xcd_barrier_complete(bar, b.x, nloc, nx); b.st[0] = nloc; b.st[1] = nx; }
        const unsigned old = xb_add(&bar[XB_XSUB(b.x)], 1u);
        const unsigned gen = old / nloc;
        if (old + 1u == (gen + 1u) * nloc) {
            __builtin_amdgcn_fence(__ATOMIC_RELEASE, "agent");
            asm volatile("s_waitcnt vmcnt(0)" ::: "memory");
            const unsigned og = xb_add(&bar[XB_TOP], 1u);
            const unsigned tg = og / nx;
            if (og + 1u == (tg + 1u) * nx) xb_add(&bar[XB_TOPGEN], 1u);
            else XB_SPIN(xb_ld(&bar[XB_TOPGEN]) == tg, bar);
            __builtin_amdgcn_fence(__ATOMIC_ACQUIRE, "agent");
            xb_add(&bar[XB_XGEN(b.x)], 1u);
            asm volatile("s_waitcnt vmcnt(0)" ::: "memory");
        } else {
            XB_SPIN(xb_ld(&bar[XB_XGEN(b.x)]) == gen, bar);
            __builtin_amdgcn_fence(__ATOMIC_ACQUIRE, "agent");
            asm volatile("s_waitcnt vmcnt(0)" ::: "memory");
        }
    }
    __syncthreads();
}
namespace att {
using f32x16 = __attribute__((ext_vector_type(16))) float;
using s16x4  = __attribute__((ext_vector_type(4))) short;
constexpr int NW = 8, QBLK = 32, KVBLK = 64;
constexpr float SCALE = 0.07216878364870322f;
constexpr float THR = 8.f;
constexpr int SHM_V = KVBLK * VH * 2, SHM_K = KVBLK * QKH * 2;
constexpr int NSLOT = 3;
constexpr int LDS_KR = 0, LDS_VR = NSLOT * SHM_K, LDS_WSF = LDS_VR + NSLOT * SHM_V, LDS_GQ = LDS_WSF + NW * 64 * 4, SHM_ATTN = LDS_GQ + 768;
#define KSWZ(row, ch) ((row) * 384 + ((((ch) ^ (((row) >> 1) & 7))) << 4))
#define SBAR() __builtin_amdgcn_sched_barrier(0)
__device__ __forceinline__ int crow(int r, int hi) { return (r & 3) + 8 * (r >> 2) + 4 * hi; }
__device__ __forceinline__ unsigned cvtpk(float lo, float hi) { unsigned r; asm volatile("v_cvt_pk_bf16_f32 %0, %1, %2" : "=v"(r) : "v"(lo), "v"(hi)); return r; }

__device__ __forceinline__ void partialSM(f32x16& p0, f32x16& p1, float& m_reg, float& mn, float& alpha, bool visible) {
  constexpr float C = SCALE * 1.4426950408889634f;
  if (__builtin_expect(!visible, 0)) { for (int r = 0; r < 16; ++r) { p0[r] = -1e30f; p1[r] = -1e30f; } asm volatile("" : "+v"(p0), "+v"(p1)); }
  float pmax = p0[0]; for (int r = 1; r < 16; ++r) pmax = fmaxf(pmax, p0[r]); for (int r = 0; r < 16; ++r) pmax = fmaxf(pmax, p1[r]);
  { auto rr = __builtin_amdgcn_permlane32_swap(__float_as_uint(pmax), __float_as_uint(pmax), false, false);
    pmax = fmaxf(__uint_as_float(rr[0]), __uint_as_float(rr[1])); }
  if (__builtin_expect(__all(pmax - m_reg <= THR / SCALE), 1)) { mn = m_reg; alpha = 1.f; }
  else { mn = fmaxf(m_reg, pmax); alpha = __builtin_amdgcn_exp2f((m_reg - mn) * C); m_reg = mn; }
  float mnC = -mn * C;
  for (int r = 0; r < 16; ++r) p0[r] = fmaf(p0[r], C, mnC); for (int r = 0; r < 16; ++r) p1[r] = fmaf(p1[r], C, mnC);
  for (int r = 0; r < 16; ++r) p0[r] = __builtin_amdgcn_exp2f(p0[r]);
}
__device__ __forceinline__ void finishSM(f32x16& p0, f32x16& p1, float alpha, float& l_reg, bf16x8& pa0, bf16x8& pa1, bf16x8& pa2, bf16x8& pa3) {
  for (int r = 0; r < 16; ++r) p1[r] = __builtin_amdgcn_exp2f(p1[r]);
  float ps = 0; for (int r = 0; r < 16; ++r) ps += p0[r]; for (int r = 0; r < 16; ++r) ps += p1[r];
  { auto rr = __builtin_amdgcn_permlane32_swap(__float_as_uint(ps), __float_as_uint(ps), false, false);
    ps = __uint_as_float(rr[0]) + __uint_as_float(rr[1]); }
  l_reg = l_reg * alpha + ps;
#define PK4(P, BASE, OUT) do { unsigned a0 = cvtpk(P[BASE + 0], P[BASE + 1]), a1 = cvtpk(P[BASE + 2], P[BASE + 3]);   \
    unsigned b0 = cvtpk(P[BASE + 4], P[BASE + 5]), b1 = cvtpk(P[BASE + 6], P[BASE + 7]);                              \
    auto r0 = __builtin_amdgcn_permlane32_swap(a0, b0, false, false); auto r1 = __builtin_amdgcn_permlane32_swap(a1, b1, false, false); \
    u32x4 w = {r0[0], r1[0], r0[1], r1[1]}; OUT = *reinterpret_cast<bf16x8*>(&w); } while (0)
  PK4(p0, 0, pa0); PK4(p0, 8, pa1); PK4(p1, 0, pa2); PK4(p1, 8, pa3);
#undef PK4
}
__device__ __forceinline__ void qkt(f32x16& p0, f32x16& p1, const int (&ka)[4], int slot_off, const bf16x8* qr) {
  constexpr int PD = 2;
  bf16x8 kf0[12], kf1[12]; int kb[4];
#pragma unroll
  for (int jj = 0; jj < 4; ++jj) kb[jj] = ka[jj] + slot_off;
  p0 = f32x16{}; p1 = f32x16{};
#define QK_ISSUE(s) do { \
    asm volatile("ds_read_b128 %0, %1 offset:%c2" : "=v"(kf0[s]) : "v"(kb[(s) & 3]), "i"(((s) >> 2) * 128) : "memory"); \
    asm volatile("ds_read_b128 %0, %1 offset:%c2" : "=v"(kf1[s]) : "v"(kb[(s) & 3]), "i"(((s) >> 2) * 128 + 12288) : "memory"); } while (0)
#pragma unroll
  for (int s = 0; s < PD; ++s) QK_ISSUE(s);
#pragma unroll
  for (int d0 = 0; d0 < 12; ++d0) {
    if (d0 + PD < 12) QK_ISSUE(d0 + PD);
    const int later = 2 * ((d0 + PD < 12 ? d0 + PD : 11) - d0);
    asm volatile("s_waitcnt lgkmcnt(%c2)" : "+v"(kf0[d0]), "+v"(kf1[d0]) : "i"(later));
    p0 = __builtin_amdgcn_mfma_f32_32x32x16_bf16(kf0[d0], qr[d0], p0, 0, 0, 0);
    p1 = __builtin_amdgcn_mfma_f32_32x32x16_bf16(kf1[d0], qr[d0], p1, 0, 0, 0);
  }
#undef QK_ISSUE
}
__device__ __forceinline__ void glds16(const void* gsrc, unsigned lds_dst) { unsigned keep;
  asm volatile("s_mov_b32 %0, m0\n\ts_mov_b32 m0, %2\n\ts_nop 0\n\tglobal_load_lds_dwordx4 %1, off\n\ts_mov_b32 m0, %0" : "=&s"(keep) : "v"(gsrc), "s"(lds_dst) : "memory"); }
__device__ __forceinline__ int v_st(int k, int c) { const int kk = (k & ~0xC) | ((k & 4) << 1) | ((k & 8) >> 1); return ((kk >> 3) * 4 + (c >> 5)) * 512 + ((kk & 7) * 32 + (c & 31)) * 2; }
__device__ __forceinline__ int v_rd_base(int lane) { return ((lane & 3) << 3) | (((lane >> 2) & 3) << 6) | (((lane >> 4) & 1) << 5) | (((lane >> 5) & 1) << 8); }
constexpr int v_rd_off(int d0, int ks, int half) { return d0 * 512 + ks * 4096 + half * 2048; }
template <int OFF> __device__ __forceinline__ s16x4 tr_read(int vb) {
  s16x4 r; asm volatile("ds_read_b64_tr_b16 %0, %1 offset:%2" : "=&v"(r) : "v"(vb), "i"(OFF) : "memory"); return r;
}
template <int KS> __device__ __forceinline__ void pv_ks(f32x16* o, int vb, bf16x8 pa) {
  const s16x4 l0 = tr_read<v_rd_off(0, KS, 0)>(vb), h0 = tr_read<v_rd_off(0, KS, 1)>(vb), l1 = tr_read<v_rd_off(1, KS, 0)>(vb), h1 = tr_read<v_rd_off(1, KS, 1)>(vb);
  const s16x4 l2 = tr_read<v_rd_off(2, KS, 0)>(vb), h2 = tr_read<v_rd_off(2, KS, 1)>(vb), l3 = tr_read<v_rd_off(3, KS, 0)>(vb), h3 = tr_read<v_rd_off(3, KS, 1)>(vb);
  asm volatile("s_waitcnt lgkmcnt(0)" ::: "memory"); SBAR();
#define PK(L, H) (bf16x8){L[0], L[1], L[2], L[3], H[0], H[1], H[2], H[3]}
  o[0] = __builtin_amdgcn_mfma_f32_32x32x16_bf16(pa, PK(l0, h0), o[0], 0, 0, 0);
  o[1] = __builtin_amdgcn_mfma_f32_32x32x16_bf16(pa, PK(l1, h1), o[1], 0, 0, 0);
  o[2] = __builtin_amdgcn_mfma_f32_32x32x16_bf16(pa, PK(l2, h2), o[2], 0, 0, 0);
  o[3] = __builtin_amdgcn_mfma_f32_32x32x16_bf16(pa, PK(l3, h3), o[3], 0, 0, 0);
#undef PK
}
__device__ __forceinline__ void pv_d0(f32x16* o, int vb, bf16x8 pa0, bf16x8 pa1, bf16x8 pa2, bf16x8 pa3) {
  pv_ks<0>(o, vb, pa0); pv_ks<1>(o, vb, pa1); pv_ks<2>(o, vb, pa2); pv_ks<3>(o, vb, pa3);
}

__device__ __forceinline__ void attn_unit(const bf16_t* __restrict__ Qh, const bf16_t* __restrict__ Kh, const bf16_t* __restrict__ Vh,
                                          const bf16_t* Gt, bf16_t* Ot  , int qb, char* lds,
                                          const float* __restrict__ gq, const float* __restrict__ cs_b, const float* __restrict__ sn_b) {
  int tid_l = threadIdx.x; asm volatile("" : "+v"(tid_l));
  const int tid = tid_l, wid = __builtin_amdgcn_readfirstlane(tid >> 6), lane = tid & 63, r32 = lane & 31, hi = lane >> 5;
  const unsigned lds0 = (unsigned)(uintptr_t)lds;
  const float* gl = (const float*)(lds + LDS_GQ);
  float* ws = (float*)(lds + LDS_WSF) + wid * 64; float* li_l = ws; float* al_l = ws + 32;
  float m_reg = -1e30f, l_reg = 0; f32x16 o[4] = {}; bf16x8 qr[12];
  const int q0 = qb * 256;
  const bf16_t* Qw = Qh + (size_t)(q0 + wid * QBLK + r32) * QKH + hi * 8;
  int gko[3], gvo[2];
#pragma unroll
  for (int i = 0; i < 3; ++i) { const int q = (i * 8 + wid) * 64 + lane, row = q / 24, chs = q - row * 24, ch = chs ^ ((row >> 1) & 7); gko[i] = row * QKH + ch * 8; }
#pragma unroll
  for (int i = 0; i < 2; ++i) { const int q = (i * 8 + wid) * 64 + lane, st = q >> 5, kk = (st >> 2) * 8 + ((q & 31) >> 2), cc = (st & 3) * 32 + (q & 3) * 8;
    const int k = (kk & ~0xC) | ((kk & 4) << 1) | ((kk & 8) >> 1); gvo[i] = k * VH + cc; }
#define DMA_K(t, slot) do { _Pragma("unroll") for (int i_ = 0; i_ < 3; ++i_) glds16(Kh + (size_t)(t) * (KVBLK * QKH) + gko[i_], (unsigned)__builtin_amdgcn_readfirstlane(lds0 + LDS_KR + (slot) * SHM_K + (i_ * 8 + wid) * 1024)); } while (0)
#define DMA_V(t, slot) do { _Pragma("unroll") for (int i_ = 0; i_ < 2; ++i_) glds16(Vh + (size_t)(t) * (KVBLK * VH) + gvo[i_], (unsigned)__builtin_amdgcn_readfirstlane(lds0 + LDS_VR + (slot) * SHM_V + (i_ * 8 + wid) * 1024)); } while (0)
#define WAITBAR(N) asm volatile("s_waitcnt vmcnt(" #N ") lgkmcnt(0)\n\ts_barrier" ::: "memory")
  DMA_K(0, 0); DMA_V(0, 0); DMA_K(1, 1);
  {
    float xq[12][8]; float ss = 0.f;
#pragma unroll
    for (int d0 = 0; d0 < 12; ++d0) { const u32x4 w = __builtin_nontemporal_load(reinterpret_cast<const u32x4*>(Qw + d0 * 16));
      xq[d0][0] = bflo(w.x); xq[d0][1] = bfhi(w.x); xq[d0][2] = bflo(w.y); xq[d0][3] = bfhi(w.y); xq[d0][4] = bflo(w.z); xq[d0][5] = bfhi(w.z); xq[d0][6] = bflo(w.w); xq[d0][7] = bfhi(w.w);
#pragma unroll
      for (int k = 0; k < 8; ++k) ss += xq[d0][k] * xq[d0][k]; }
    { auto rr = __builtin_amdgcn_permlane32_swap(__float_as_uint(ss), __float_as_uint(ss), false, false); ss = __uint_as_float(rr[0]) + __uint_as_float(rr[1]); }
    const float rinv = 1.0f / sqrtf(ss * (1.0f / QKH) + EPS);
#pragma unroll
    for (int d0 = 0; d0 < 12; ++d0) { const f32x4 g0 = *(const f32x4*)(gl + d0 * 16 + hi * 8), g1 = *(const f32x4*)(gl + d0 * 16 + hi * 8 + 4);
#pragma unroll
      for (int k = 0; k < 4; ++k) { xq[d0][k] *= rinv * g0[k]; xq[d0][4 + k] *= rinv * g1[k]; } }
    const size_t trow = (size_t)(q0 + wid * QBLK + r32) * 32 + hi * 8;
#pragma unroll
    for (int p = 0; p < 2; ++p) { const f32x4 c0 = *(const f32x4*)(cs_b + trow + p * 16), c1 = *(const f32x4*)(cs_b + trow + p * 16 + 4), s0 = *(const f32x4*)(sn_b + trow + p * 16), s1 = *(const f32x4*)(sn_b + trow + p * 16 + 4);
#pragma unroll
      for (int k = 0; k < 8; ++k) { const float cc = k < 4 ? c0[k & 3] : c1[k & 3], sv = k < 4 ? s0[k & 3] : s1[k & 3]; const float a = xq[8 + p][k], b = xq[10 + p][k];
        xq[8 + p][k] = a * cc - b * sv; xq[10 + p][k] = b * cc + a * sv; } }
#pragma unroll
    for (int d0 = 0; d0 < 12; ++d0) { u32x4 w; w.x = cvtpk(xq[d0][0], xq[d0][1]); w.y = cvtpk(xq[d0][2], xq[d0][3]); w.z = cvtpk(xq[d0][4], xq[d0][5]); w.w = cvtpk(xq[d0][6], xq[d0][7]);
      qr[d0] = __builtin_bit_cast(bf16x8, w); }
  }
  int ka[4];
#pragma unroll
  for (int jj = 0; jj < 4; ++jj) ka[jj] = (int)(lds0 + LDS_KR) + r32 * 384 + (((2 * jj + hi) ^ ((r32 >> 1) & 7)) << 4);
  const int jmax = (q0 + wid * QBLK) >> 6;
  const int vb0 = (int)(lds0 + LDS_VR) + v_rd_base(lane);
#define RESC(a) do { if (__any((a) < 1.f)) { if (hi == 0) al_l[r32] = (a); asm volatile("s_waitcnt lgkmcnt(0)" ::: "memory"); \
    for (int d = 0; d < 4; ++d) for (int r = 0; r < 16; ++r) o[d][r] *= al_l[crow(r, hi)]; } } while (0)
  f32x16 pA0, pA1, pB0, pB1; float mnA, mnB, alA, alB; bf16x8 pa0, pa1, pa2, pa3; const int NT = (q0 + 256) / KVBLK;
  int s0 = 0, s1 = 1, s2 = 2;
#define ROT() do { const int t_ = s0; s0 = s1; s1 = s2; s2 = t_; } while (0)
  WAITBAR(0);
  DMA_K(2, s2); DMA_V(1, s1);
  qkt(pA0, pA1, ka, s0 * SHM_K, qr); partialSM(pA0, pA1, m_reg, mnA, alA, true);
  WAITBAR(5); ROT();
  for (int j = 1; j + 1 < NT; j += 2) {
    DMA_K(j + 2, s2); DMA_V(j + 1, s1);
    if (j <= jmax) { SBAR(); qkt(pB0, pB1, ka, s0 * SHM_K, qr); }
    if (j - 1 <= jmax) { finishSM(pA0, pA1, alA, l_reg, pa0, pa1, pa2, pa3); SBAR();
      pv_d0(o, vb0 + s2 * SHM_V, pa0, pa1, pa2, pa3); }
    if (j <= jmax) { partialSM(pB0, pB1, m_reg, mnB, alB, true); RESC(alB); }
    WAITBAR(5); ROT();
    const bool more = j + 3 < NT;
    if (more) DMA_K(j + 3, s2);
    DMA_V(j + 2, s1);
    if (j + 1 <= jmax) { SBAR(); qkt(pA0, pA1, ka, s0 * SHM_K, qr); }
    if (j <= jmax) { finishSM(pB0, pB1, alB, l_reg, pa0, pa1, pa2, pa3); SBAR();
      pv_d0(o, vb0 + s2 * SHM_V, pa0, pa1, pa2, pa3); }
    if (j + 1 <= jmax) { partialSM(pA0, pA1, m_reg, mnA, alA, true); RESC(alA); }
    if (more) WAITBAR(5); else WAITBAR(2);
    ROT();
  }
  if (NT - 1 <= jmax) { SBAR(); qkt(pB0, pB1, ka, s0 * SHM_K, qr); }
  if (NT - 2 <= jmax) { finishSM(pA0, pA1, alA, l_reg, pa0, pa1, pa2, pa3); SBAR();
    pv_d0(o, vb0 + s2 * SHM_V, pa0, pa1, pa2, pa3); }
  if (NT - 1 <= jmax) { partialSM(pB0, pB1, m_reg, mnB, alB, true); RESC(alB); }
  WAITBAR(0);
  if (NT - 1 <= jmax) { finishSM(pB0, pB1, alB, l_reg, pa0, pa1, pa2, pa3); SBAR();
    pv_d0(o, vb0 + s0 * SHM_V, pa0, pa1, pa2, pa3); }
  if (hi == 0) li_l[r32] = l_reg; asm volatile("s_waitcnt lgkmcnt(0)" ::: "memory");
  float rli[16];
#pragma unroll
  for (int r = 0; r < 16; ++r) rli[r] = __builtin_amdgcn_rcpf(li_l[crow(r, hi)]);
  const size_t rowb = (size_t)(q0 + wid * QBLK);
  float* stg = (float*)(lds + LDS_KR + wid * 8192);
#pragma unroll
  for (int hh = 0; hh < 2; ++hh) {
#pragma unroll
    for (int r = 0; r < 16; ++r) { const int orow = crow(r, hi);
      stg[orow * 64 + r32] = o[2 * hh][r] * rli[r]; stg[orow * 64 + 32 + r32] = o[2 * hh + 1][r] * rli[r]; }
#pragma unroll
    for (int i = 0; i < 4; ++i) { const int row = i * 8 + (lane >> 3), ch = lane & 7;
      const f32x4 a = *(const f32x4*)(stg + row * 64 + ch * 8), b = *(const f32x4*)(stg + row * 64 + ch * 8 + 4);
      const size_t off = (rowb + row) * WB + hh * 64 + ch * 8;
      const u32x4 g = __builtin_nontemporal_load((const u32x4*)(Gt + off));
      u32x4 w; w.x = cvtpk(a[0] * bflo(g.x), a[1] * bfhi(g.x)); w.y = cvtpk(a[2] * bflo(g.y), a[3] * bfhi(g.y)); w.z = cvtpk(b[0] * bflo(g.z), b[1] * bfhi(g.z)); w.w = cvtpk(b[2] * bflo(g.w), b[3] * bfhi(g.w));
      *(u32x4*)(Ot + off) = w; }
  }
  asm volatile("s_waitcnt lgkmcnt(0)\n\ts_barrier" ::: "memory");
#undef DMA_K
#undef DMA_V
#undef WAITBAR
#undef RESC
#undef ROT
}
#undef SBAR
}
struct Ctx { int tid, lane, wave, gw, ngw; LAS unsigned char* lds; };

__device__ __forceinline__ void transpose_item(const float* __restrict__ W, int K, int N, int ldw, bf16_t* __restrict__ WT, int row_off, const float* __restrict__ gain, LAS float* scr, int item, int lane) {
    const int nblk = N / 32, kb = item / nblk, nb = item % nblk, k0 = 64 * kb, n0 = 32 * nb;
    float wv[32];
    const float* wp = W + (size_t)(k0 + (lane >> 5)) * ldw + n0 + (lane & 31);
#pragma unroll
    for (int i = 0; i < 32; ++i) wv[i] = __builtin_nontemporal_load(wp + (size_t)(2 * i) * ldw);
    if (gain) {
#pragma unroll
        for (int i = 0; i < 32; ++i) wv[i] *= gain[k0 + 2 * i + (lane >> 5)];
    }
#pragma unroll
    for (int i = 0; i < 32; ++i) scr[(2 * i + (lane >> 5)) * 33 + (lane & 31)] = wv[i];
    asm volatile("s_waitcnt lgkmcnt(0)" ::: "memory");
    const int c = lane & 7;
#pragma unroll
    for (int j = 0; j < 4; ++j) { const int n = (lane >> 3) + 8 * j; const LAS float* s = scr + (8 * c) * 33 + n;
        u32x4 o; o.x = pk2(s[0 * 33], s[1 * 33]); o.y = pk2(s[2 * 33], s[3 * 33]); o.z = pk2(s[4 * 33], s[5 * 33]); o.w = pk2(s[6 * 33], s[7 * 33]);
        *(u32x4*)(WT + (size_t)(row_off + n0 + n) * K + k0 + 8 * c) = o; }
    asm volatile("s_waitcnt lgkmcnt(0)" ::: "memory");
}
__device__ __forceinline__ void convert_weight(const Ctx& c, const float* W, int K, int N, bf16_t* WT, int row_off, const float* gain, int ldw = 0) {
    LAS float* scr = (LAS float*)(c.lds + c.wave * 16384);
    const int nitems = (K / 64) * (N / 32);
    for (int it = c.gw; it < nitems; it += c.ngw) transpose_item(W, K, N, ldw ? ldw : N, WT, row_off, gain, scr, it, c.lane);
}
__device__ __forceinline__ void convert_plain(const Ctx& c, const float* __restrict__ W, int K, int ncols, int ldw, bf16_t* __restrict__ out, int ldo, int coff, const float* __restrict__ gain) {
    const int per_row = ncols / 8, total = K * per_row, stride = c.ngw * 64;
    for (int i0 = c.gw * 64 + c.lane; i0 < total; i0 += 4 * stride) {
        f32x4 a[4], b[4]; int kk[4], cc[4];
#pragma unroll
        for (int u = 0; u < 4; ++u) { const int i = i0 + u * stride; const bool ok = i < total; const int ii = ok ? i : i0; kk[u] = ii / per_row; cc[u] = (ii - kk[u] * per_row) * 8;
            a[u] = __builtin_nontemporal_load((const f32x4*)(W + (size_t)kk[u] * ldw + cc[u])); b[u] = __builtin_nontemporal_load((const f32x4*)(W + (size_t)kk[u] * ldw + cc[u] + 4)); }
#pragma unroll
        for (int u = 0; u < 4; ++u) { if (i0 + u * stride < total) { const float g = gain[kk[u]]; *(u32x4*)(out + (size_t)kk[u] * ldo + coff + cc[u]) = pack8(a[u] * g, b[u] * g); } }
    }
}
__device__ __forceinline__ void xprep_rows(const Ctx& c, const float* __restrict__ x, bf16_t* __restrict__ xb, float* __restrict__ ssq) {
    for (int r = c.gw; r < MTOK; r += c.ngw) {
        const f32x4* xr = (const f32x4*)(x + (size_t)r * DM) + c.lane;
        f32x4 v[8]; float s = 0.f;
#pragma unroll
        for (int j = 0; j < 8; ++j) { v[j] = __builtin_nontemporal_load(xr + 64 * j); s += (v[j].x * v[j].x + v[j].y * v[j].y) + (v[j].z * v[j].z + v[j].w * v[j].w); }
        s = wave_sum(s);
        if (c.lane == 0) ssq[r] = s;
        u32x2* o = (u32x2*)(xb + (size_t)r * DM) + c.lane;
#pragma unroll
        for (int j = 0; j < 8; ++j) { u32x2 w; w.x = pk2(v[j].x, v[j].y); w.y = pk2(v[j].z, v[j].w); o[64 * j] = w; }
    }
}
__device__ __forceinline__ void rope_tables(const Ctx& c, const int* __restrict__ pos, float* __restrict__ cs, float* __restrict__ sn) {
    const int gt = c.gw * 64 + c.lane, ngt = c.ngw * 64;
    for (int i = gt; i < MTOK * 32; i += ngt) {
        const int t = i >> 5, f = i & 31;
        const float inv = exp2f(-(float)f * 0.41524101186092029f);
        const float ang = (float)pos[t] * inv;
        float sd, cd; sincosf(ang, &sd, &cd);
        cs[i] = cd; sn[i] = sd;
    }
}
__device__ __forceinline__ void load8(const bf16_t* p, float* f) { const u32x4 w = __builtin_nontemporal_load((const u32x4*)p); f[0] = bflo(w.x); f[1] = bfhi(w.x); f[2] = bflo(w.y); f[3] = bfhi(w.y); f[4] = bflo(w.z); f[5] = bfhi(w.z); f[6] = bflo(w.w); f[7] = bfhi(w.w); }
__device__ __forceinline__ void pool_phase(const Ctx& c, const bf16_t* __restrict__ U, bf16_t* __restrict__ P, const bf16_t* __restrict__ G, const float* __restrict__ scale) {
    constexpr int SEGL = 64, NSEG = MTOK / SEGL;
    for (int seg = blockIdx.x; seg < NSEG; seg += gridDim.x) {
        const int t0 = seg * SEGL, s0 = t0 & (SEQ - 1), col = c.tid * 8, w = 2 << (col >> 10);
        const bf16_t* Uc = U + col; bf16_t* Pc = P + col; const bf16_t* Gc = G + col;
        float sc[8];
#pragma unroll
        for (int k = 0; k < 8; ++k) sc[k] = scale[col + k];
        float sum[8];
#pragma unroll
        for (int k = 0; k < 8; ++k) sum[k] = 0.f;
        for (int i = 1; i <= w; ++i) { if (s0 - i >= 0) { float f[8]; load8(Uc + (size_t)(t0 - i) * WA, f);
#pragma unroll
            for (int k = 0; k < 8; ++k) sum[k] += f[k]; } }
        const float rw = 1.0f / (float)w;
#pragma unroll 4
        for (int i = 0; i < SEGL; ++i) {
            const int t = t0 + i, s = s0 + i; float f[8], old[8];
            load8(Uc + (size_t)t * WA, f);
            if (s >= w) load8(Uc + (size_t)(t - w) * WA, old); else {
#pragma unroll
                for (int k = 0; k < 8; ++k) old[k] = 0.f; }
            const float rc = (s + 1 < w) ? 1.0f / (float)(s + 1) : rw;
            float o[8], gt[8]; load8(Gc + (size_t)t * WA, gt);
#pragma unroll
            for (int k = 0; k < 8; ++k) { sum[k] += f[k] - old[k]; o[k] = (sum[k] * rc - f[k]) * sc[k] * gt[k]; }
            u32x4 pw; pw.x = pk2(o[0], o[1]); pw.y = pk2(o[2], o[3]); pw.z = pk2(o[4], o[5]); pw.w = pk2(o[6], o[7]);
            *(u32x4*)(Pc + (size_t)t * WA) = pw;
        }
    }
}
template <bool ISK>
__device__ __forceinline__ void qknorm_rope(const Ctx& c, bf16_t* __restrict__ T, const float* __restrict__ KR, const float* __restrict__ g, const float* __restrict__ cs, const float* __restrict__ sn) {
    const int l = c.lane & 7, sub = c.lane >> 3;
    float gn[16], g1[4], g2[4];
#pragma unroll
    for (int k = 0; k < 16; ++k) gn[k] = g[16 * l + k];
#pragma unroll
    for (int k = 0; k < 4; ++k) { g1[k] = g[128 + 4 * l + k]; g2[k] = g[160 + 4 * l + k]; }
    const int nvec = MTOK * NH;
    for (int v = c.gw * 8 + sub; v < nvec; v += c.ngw * 8) {
        const int s = v & (SEQ - 1), bh = v >> 12, tok = (bh >> 4) * SEQ + s;
        bf16_t* p = T + (size_t)v * QKH;
        float x[16], t1[4], t2[4];
        load8(p + 16 * l, x); load8(p + 16 * l + 8, x + 8);
        if (ISK) { const f32x4 a = *(const f32x4*)(KR + (size_t)tok * 64 + 4 * l), b = *(const f32x4*)(KR + (size_t)tok * 64 + 32 + 4 * l);
#pragma unroll
            for (int k = 0; k < 4; ++k) { t1[k] = a[k]; t2[k] = b[k]; } }
        else { const u32x2 a = *(const u32x2*)(p + 128 + 4 * l), b = *(const u32x2*)(p + 160 + 4 * l);
            t1[0] = bflo(a.x); t1[1] = bfhi(a.x); t1[2] = bflo(a.y); t1[3] = bfhi(a.y); t2[0] = bflo(b.x); t2[1] = bfhi(b.x); t2[2] = bflo(b.y); t2[3] = bfhi(b.y); }
        float ss = 0.f;
#pragma unroll
        for (int k = 0; k < 16; ++k) ss += x[k] * x[k];
#pragma unroll
        for (int k = 0; k < 4; ++k) ss += t1[k] * t1[k] + t2[k] * t2[k];
        ss += __shfl_xor(ss, 1); ss += __shfl_xor(ss, 2); ss += __shfl_xor(ss, 4);
        const float rinv = 1.0f / sqrtf(ss * (1.0f / QKH) + EPS);
        const f32x4 cc = *(const f32x4*)(cs + (size_t)tok * 32 + 4 * l), sv = *(const f32x4*)(sn + (size_t)tok * 32 + 4 * l);
        u32x4 w0, w1;
#pragma unroll
        for (int k = 0; k < 16; ++k) x[k] *= rinv * gn[k];
        w0.x = pk2(x[0], x[1]); w0.y = pk2(x[2], x[3]); w0.z = pk2(x[4], x[5]); w0.w = pk2(x[6], x[7]);
        w1.x = pk2(x[8], x[9]); w1.y = pk2(x[10], x[11]); w1.z = pk2(x[12], x[13]); w1.w = pk2(x[14], x[15]);
        float o1[4], o2[4];
#pragma unroll
        for (int k = 0; k < 4; ++k) { const float a = t1[k] * rinv * g1[k], b = t2[k] * rinv * g2[k]; o1[k] = a * cc[k] - b * sv[k]; o2[k] = b * cc[k] + a * sv[k]; }
        *(u32x4*)(p + 16 * l) = w0; *(u32x4*)(p + 16 * l + 8) = w1;
        u32x2 r1, r2; r1.x = pk2(o1[0], o1[1]); r1.y = pk2(o1[2], o1[3]); r2.x = pk2(o2[0], o2[1]); r2.y = pk2(o2[2], o2[3]);
        *(u32x2*)(p + 128 + 4 * l) = r1; *(u32x2*)(p + 160 + 4 * l) = r2;
    }
}
struct Args { const void* in[18]; float* out; unsigned char* ws; };
enum { I_X = 0, I_POS, I_ANG, I_AWIN, I_AWG, I_ASC, I_AWOUT, I_KVNG, I_KVWA, I_KVLG, I_KVWB, I_KNG, I_BNG, I_BWIN, I_BQLG, I_BWQB, I_BQNG, I_BWOUT };

#define GEMM_RUN_M(EPI, M_, gA, gB, N_, K_, LDA, LDB, AGD, AGS, BGD, BGS, ...) do { \
    pg8::Gemm g_{(const bf16_t*)(gA), (const bf16_t*)(gB), (M_), (N_), (K_), (LDA), (LDB), (AGD), (AGS), (BGD), (BGS)}; pg8::StaticOrder S_; S_.init((M_), (N_), (int)gridDim.x, (int)blockIdx.x); \
    EPI E_{__VA_ARGS__}; pg8::gemm_phase<EPI, pg8::StaticOrder, EPI::ALIGN, true>(c.lds, g_, S_, E_); } while (0)
#define GEMM_RUN(EPI, gA, gB, N_, K_, LDA, LDB, AGD, AGS, ...) GEMM_RUN_M(EPI, MTOK, gA, gB, N_, K_, LDA, LDB, AGD, AGS, NOGRP, 0, __VA_ARGS__)
constexpr int NOGRP = 1 << 30;

typedef const __attribute__((address_space(4))) Args* ArgsP;
__device__ __forceinline__ ArgsP get_args() { auto p = __builtin_amdgcn_kernarg_segment_ptr(); asm volatile("" : "+s"(p)); return (ArgsP)p; }
__device__ __forceinline__ Ctx make_ctx(unsigned char* lds_raw) {
    Ctx c; int tid = threadIdx.x; asm volatile("" : "+v"(tid)); c.tid = tid; c.lane = tid & 63; c.wave = __builtin_amdgcn_readfirstlane(tid >> 6); c.gw = blockIdx.x * 8 + c.wave; c.ngw = gridDim.x * 8; c.lds = (LAS unsigned char*)lds_raw; return c;
}
#define PHASE_BEGIN ArgsP ap = get_args(); unsigned char* ws = ap->ws; const Ctx c = make_ctx(lds_raw); (void)ws; (void)c;
#define INF(k) ((const float*)ap->in[k])
#define WSB(off) ((bf16_t*)(ws + (off)))
#define WSF(off) ((float*)(ws + (off)))

#define GRID_BAR() do { ArgsP ap_ = get_args(); XcdBarrier b_; b_.bar = (unsigned*)(ap_->ws + WS_BAR); b_.x = xb_xcc_id(); b_.st = (volatile LAS unsigned*)((LAS unsigned char*)lds_raw + MISC_OFF); xcd_barrier(b_); } while (0)

__global__ void __launch_bounds__(512, 2) yoco_fwd(Args a_unused) {
    extern __shared__ __attribute__((aligned(16))) unsigned char lds_raw[];
    cg::grid_group grid = cg::this_grid();
    if (threadIdx.x < 2) ((LAS unsigned*)((LAS unsigned char*)lds_raw + MISC_OFF))[threadIdx.x] = 0u;
    { ArgsP ap_ = get_args(); if (threadIdx.x == 0) (void)xb_add((unsigned*)(ap_->ws + WS_BAR) + XB_XCNT(xb_xcc_id()), 1u); }
    __syncthreads();

    {
        PHASE_BEGIN
        rope_tables(c, (const int*)ap->in[I_POS], WSF(WS_COS), WSF(WS_SIN));
        { float* z = WSF(WS_SSQC); for (int i = c.gw * 64 + c.lane; i < 3 * MTOK; i += c.ngw * 64) z[i] = 0.f; }
        { float* z = WSF(WS_SSQX) + MTOK; for (int i = c.gw * 64 + c.lane; i < 4 * MTOK; i += c.ngw * 64) z[i] = 0.f; }
        xprep_rows(c, INF(I_X), (bf16_t*)ap->out, WSF(WS_SSQX));
#pragma unroll 1
        for (int l = 0; l < 2; ++l) {
            const float* win = INF(I_AWIN) + (size_t)l * DM * 2 * WA; const float* gl = INF(I_ANG) + l * DM;
#pragma unroll 1
            for (int g = 0; g < 4; ++g) convert_weight(c, INF(I_AWG) + ((size_t)l * 4 + g) * GA * GA, GA, GA, WSB(WS_AWGB), l * WA + g * GA, nullptr);
            convert_plain(c, win, DM, WA, 2 * WA, WSB(WS_WINUB), 2 * WA, l * WA, gl);
            convert_weight(c, win + WA, DM, WA, WSB(l ? WS_A1WIN : WS_AWIN), WA, gl, 2 * WA);
            convert_weight(c, INF(I_AWOUT) + (size_t)l * WA * DM, WA, DM, WSB(l ? WS_A1WOUT : WS_AWOUT), 0, nullptr);
        }
    }
    if (gridDim.x == 0x7fffffffu) grid.sync();
    GRID_BAR();
    {
        PHASE_BEGIN
        GEMM_RUN_M(EpiWp, 2 * WA, WSB(WS_AWGB), WSB(WS_WINUB), DM, GA, GA, 2 * WA, NOGRP, 0, 4, GA, WSB(WS_AWIN), WSB(WS_A1WIN));
    }
    GRID_BAR();
#pragma unroll 1
    for (int l = 0; l < 2; ++l) {
        {
            PHASE_BEGIN
            GEMM_RUN(EpiA1, (bf16_t*)ap->out + (size_t)l * MTOK * DM, WSB(l ? WS_A1WIN : WS_AWIN), 2 * WA, DM, DM, DM, NOGRP, 0, WSB(l ? WS_R0 : WS_R1), WSB(WS_G), WSF(WS_SSQX) + l * MTOK);
        }
        GRID_BAR();
        {
            PHASE_BEGIN
            pool_phase(c, WSB(l ? WS_R0 : WS_R1), WSB(l ? WS_R1 : WS_R0), WSB(WS_G), INF(I_ASC) + l * WA);
            if (l == 1) {
                bf16_t* WC0 = WSB(WS_BWC0);
                convert_weight(c, INF(I_KVWA), DM, KVL + QKR, WC0, 0, INF(I_KVNG));
                { u32x4* z = (u32x4*)(WC0 + (size_t)(KVL + QKR) * DM); const int n16 = 192 * DM * 2 / 16; for (int i = c.gw * 64 + c.lane; i < n16; i += c.ngw * 64) z[i] = (u32x4){0u, 0u, 0u, 0u}; }
                convert_weight(c, INF(I_BWIN), DM, QL_ + WB, WC0, 768, INF(I_BNG));
            }
        }
        GRID_BAR();
        {
            PHASE_BEGIN
            GEMM_RUN(EpiRes, WSB(l ? WS_R1 : WS_R0), WSB(l ? WS_A1WOUT : WS_AWOUT), DM, WA, WA, WA, NOGRP, 0, (const bf16_t*)ap->out + (size_t)l * MTOK * DM, (float*)nullptr, (bf16_t*)ap->out + (size_t)(1 - l) * MTOK * DM, WSF(WS_SSQX) + (l + 1) * MTOK);
        }
        GRID_BAR();
    }
#pragma unroll 1
    for (int j = 0; j < 2; ++j) {
        {
            PHASE_BEGIN
            float* ssqq = WSF(j ? WS_SSQQ1 : WS_SSQQ0);
            GEMM_RUN(EpiBin, (j ? WSB(WS_XB2) : (bf16_t*)ap->out), WSB(j ? WS_BWIN1 : WS_BWC0), j ? 2560 : 3328, DM, DM, DM, NOGRP, 0, WSB(WS_CB), WSB(WS_QL), WSB(WS_GB), WSF(WS_KR), WSF(WS_SSQC), ssqq, j ? 3 : 0, WSF(WS_SSQX) + (2 + j) * MTOK, WSF(WS_SSQKR));
        }
        {
            PHASE_BEGIN
            if (j == 0) {
                const int G_ = gridDim.x, nfull = (G_ == 256) ? 64 : 0;
                if ((int)blockIdx.x >= nfull) {
                    Ctx c2 = c; c2.gw = ((int)blockIdx.x - nfull) * 8 + c.wave; c2.ngw = (G_ - nfull) * 8;
                    convert_weight(c2, INF(I_BWIN) + (size_t)DM * (QL_ + WB), DM, QL_ + WB, WSB(WS_BWIN1), 0, INF(I_BNG) + DM);
                    convert_weight(c2, INF(I_KVWB), KVL, NH * (QKN + VH), WSB(WS_BWKVB), 0, INF(I_KVLG));
#pragma unroll 1
                    for (int jj = 0; jj < 2; ++jj) {
                        convert_weight(c2, INF(I_BWQB) + (size_t)jj * QL_ * NH * QKH, QL_, NH * QKH, WSB(jj ? WS_BWQB1 : WS_BWQB0), 0, INF(I_BQLG) + jj * QL_);
                        convert_weight(c2, INF(I_BWOUT) + (size_t)jj * WB * DM, WB, DM, WSB(jj ? WS_BWO1 : WS_BWO0), 0, nullptr);
                    }
                }
            }
        }
        GRID_BAR();
        if (j == 0) {
            PHASE_BEGIN
            GEMM_RUN(EpiKVb, WSB(WS_CB), WSB(WS_BWKVB), NH * (QKN + VH), KVL, KVL, KVL, NOGRP, 0, WSB(WS_K), WSB(WS_V), WSF(WS_SSQC), WSF(WS_SSQKR), WSF(WS_KR), INF(I_KNG), WSF(WS_COS), WSF(WS_SIN), (LAS float*)(c.lds + XCH_OFF));
        }
        {
            PHASE_BEGIN
            GEMM_RUN(EpiQb, WSB(WS_QL), WSB(j ? WS_BWQB1 : WS_BWQB0), NH * QKH, QL_, QL_, QL_, NOGRP, 0, WSB(WS_Q), WSF(j ? WS_SSQQ1 : WS_SSQQ0));
        }
        GRID_BAR();
        {
            PHASE_BEGIN
            if (c.tid < 48) ((LAS f32x4*)(c.lds + att::LDS_GQ))[c.tid] = ((const f32x4*)(INF(I_BQNG) + j * QKH))[c.tid];
            __syncthreads();
            const int G_ = gridDim.x, bx = blockIdx.x; const int vcu = (G_ % 8 == 0) ? (bx % 8) * (G_ / 8) + bx / 8 : bx;
#pragma unroll 1
            for (int slot = vcu; slot < 256; slot += G_) {
                const int bh = slot >> 2, s = slot & 3, b = bh >> 4, h = bh & 15;
#pragma unroll 1
                for (int i = 0; i < 4; ++i) {
                    const int qb = (i == 0) ? 15 - s : (i == 1) ? 8 + s : (i == 2) ? 7 - s : s;
                    att::attn_unit(WSB(WS_Q) + (size_t)bh * SEQ * QKH, WSB(WS_K) + (size_t)bh * SEQ * QKH, WSB(WS_V) + (size_t)bh * SEQ * VH,
                                   WSB(WS_GB) + (size_t)b * SEQ * WB + h * VH, WSB(WS_OG) + (size_t)b * SEQ * WB + h * VH, qb, (char*)lds_raw,
                                   INF(I_BQNG) + j * QKH, WSF(WS_COS) + (size_t)b * SEQ * 32, WSF(WS_SIN) + (size_t)b * SEQ * 32);
                }
            }
        }
        GRID_BAR();
        {
            PHASE_BEGIN
            GEMM_RUN(EpiRes, WSB(WS_OG), WSB(j ? WS_BWO1 : WS_BWO0), DM, WB, WB, WB, NOGRP, 0, (j ? (const bf16_t*)WSB(WS_XB2) : (const bf16_t*)ap->out), (j ? ap->out : (float*)nullptr), (j == 0 ? WSB(WS_XB2) : (bf16_t*)nullptr), WSF(WS_SSQX) + 3 * MTOK);
        }
        if (j == 0) GRID_BAR();
    }
}

extern "C" void kernel_launch(void* const* d_in, const int* in_sizes, int n_in, void* d_out, int out_size, void* d_ws, size_t ws_size, hipStream_t stream) {
    static int grid_blocks = 0;
    if (grid_blocks == 0) {
        if (n_in != 18 || out_size != MTOK * DM || ws_size < WS_END) { fprintf(stderr, "kernel_launch: unexpected shapes n_in %d out %d ws %zu (need %zu)\n", n_in, out_size, ws_size, (size_t)WS_END); grid_blocks = -1; return; }
        int dev = 0, cus = 0, per_cu = 0;
        (void)hipGetDevice(&dev); (void)hipDeviceGetAttribute(&cus, hipDeviceAttributeMultiprocessorCount, dev);
        if (hipFuncSetAttribute((const void*)yoco_fwd, hipFuncAttributeMaxDynamicSharedMemorySize, LDS_BYTES) != hipSuccess) { fprintf(stderr, "kernel_launch: hipFuncSetAttribute failed\n"); grid_blocks = -1; return; }
        if (hipOccupancyMaxActiveBlocksPerMultiprocessor(&per_cu, (const void*)yoco_fwd, 512, LDS_BYTES) != hipSuccess || per_cu < 1) { fprintf(stderr, "kernel_launch: occupancy query gave %d\n", per_cu); per_cu = 1; }
        (void)hipGetLastError();
        grid_blocks = cus * 1;
        fprintf(stderr, "kernel_launch: cus %d per_cu %d grid %d ws %zu\n", cus, per_cu, grid_blocks, ws_size);
    }
    if (grid_blocks < 0) return;
    if (hipMemsetAsync((char*)d_ws + WS_BAR, 0, XCD_BAR_WORDS * 4, stream) != hipSuccess) { fprintf(stderr, "kernel_launch: hipMemsetAsync failed\n"); return; }
    Args a{};
    for (int i = 0; i < 18; ++i) a.in[i] = d_in[i];
    a.out = (float*)d_out; a.ws = (unsigned char*)d_ws;
    void* args[] = {&a};
    hipError_t e = hipLaunchCooperativeKernel((const void*)yoco_fwd, dim3(grid_blocks), dim3(512), args, LDS_BYTES, stream);
    if (e != hipSuccess) fprintf(stderr, "cooperative launch failed: %s (grid %d)\n", hipGetErrorString(e), grid_blocks);
}
```
